# Optimizing an MI355X kernel written in HIP

```python
import math
import jax, jax.numpy as jnp
from jax import lax
import numpy as np

D_MODEL = 2048
BATCH = 4
SEQ = 2048
DEPTH = 1

N_HEADS_A = 8
HEAD_DIM_A = 128
D_A = N_HEADS_A * HEAD_DIM_A
MOBA_BLOCK = 256
MOBA_TOPK = 3
Q_CHUNK = 32
N_BUCKETS = 32
MAX_DISTANCE = 128
N_HEADS_B = 8
QK_DIM_B = 128
V_DIM_B = 128
D_B_QK = N_HEADS_B * QK_DIM_B
D_B = N_HEADS_B * V_DIM_B
RET_CHUNK = 128
ROT_BASE = 10000.0
D_PLE = 256
EPS = 1e-6
SPLIT_SIZES = (D_A, D_A, D_A, D_A, D_B_QK, D_B_QK, D_B, D_B, D_MODEL, D_MODEL)
D_IN = sum(SPLIT_SIZES)

kernel_name = 'hybrid_moba_retention_gated_block'


def rms_norm(x, g):
    xf = x.astype(jnp.float32)
    y = xf * lax.rsqrt(jnp.mean(xf * xf, axis=-1, keepdims=True) + EPS)
    return (y * g.astype(jnp.float32)).astype(x.dtype)


def t5_bucket(n):
    max_exact = N_BUCKETS // 2
    nf = jnp.maximum(n, 1).astype(jnp.float32)
    large = max_exact + (jnp.log(nf / max_exact) / math.log(MAX_DISTANCE / max_exact)
                         * (N_BUCKETS - max_exact)).astype(jnp.int32)
    large = jnp.minimum(large, N_BUCKETS - 1)
    return jnp.where(n < max_exact, n, large)


def moba_attention(q, k, v, rel_bias):
    B, S, H, dh = q.shape
    f32 = jnp.float32
    L = MOBA_BLOCK
    nb = -(-S // L)
    s_pad = nb * L
    pad = ((0, 0), (0, s_pad - S), (0, 0), (0, 0))
    qh = jnp.pad(q.astype(f32), pad).transpose(0, 2, 1, 3)
    kb = jnp.pad(k.astype(f32), pad).transpose(0, 2, 1, 3).reshape(B, H, nb, L, dh)
    vb = jnp.pad(v.astype(f32), pad).transpose(0, 2, 1, 3).reshape(B, H, nb, L, dh)

    k_mean = jnp.mean(kb, axis=3)
    gate = jnp.einsum('bhsd,bhnd->bhsn', qh, k_mean)
    q_blk = jnp.arange(s_pad) // L
    past = jnp.arange(nb)[None, :] < q_blk[:, None]
    gate = jnp.where(past[None, None], gate, -jnp.inf)
    n_sel = max(1, min(MOBA_TOPK, nb - 1))
    top_val, top_idx = lax.top_k(gate, n_sel)
    sel_valid = jnp.isfinite(top_val)

    scale = dh ** -0.5
    rel_bias_t = rel_bias.astype(f32).T
    bi = jnp.arange(B)[:, None, None, None]
    hi = jnp.arange(H)[None, :, None, None]
    hi5 = jnp.arange(H)[None, :, None, None, None]
    ar_q = jnp.arange(Q_CHUNK)
    ar_l = jnp.arange(L)

    def chunk(c):
        q0 = c * Q_CHUNK
        qc = lax.dynamic_slice_in_dim(qh, q0, Q_CHUNK, axis=2)
        idx = lax.dynamic_slice_in_dim(top_idx, q0, Q_CHUNK, axis=2)
        valid = lax.dynamic_slice_in_dim(sel_valid, q0, Q_CHUNK, axis=2)
        qpos = q0 + ar_q
        k_sel = kb[bi, hi, idx]
        v_sel = vb[bi, hi, idx]
        s_sel = jnp.einsum('bhqd,bhqnld->bhqnl', qc, k_sel) * scale
        kpos_sel = idx[..., None] * L + ar_l
        dist_sel = qpos[None, None, :, None, None] - kpos_sel
        s_sel = s_sel + rel_bias_t[hi5, t5_bucket(jnp.maximum(dist_sel, 0))]
        s_sel = jnp.where(valid[..., None], s_sel, -jnp.inf)
        blk = q0 // L
        k_own = lax.dynamic_index_in_dim(kb, blk, axis=2, keepdims=False)
        v_own = lax.dynamic_index_in_dim(vb, blk, axis=2, keepdims=False)
        s_own = jnp.einsum('bhqd,bhld->bhql', qc, k_own) * scale
        dist_own = qpos[:, None] - (blk * L + ar_l)[None, :]
        s_own = s_own + rel_bias_t[:, t5_bucket(jnp.maximum(dist_own, 0))][None]
        s_own = jnp.where((dist_own >= 0)[None, None], s_own, -jnp.inf)
        logits = jnp.concatenate([s_sel.reshape(B, H, Q_CHUNK, n_sel * L), s_own], axis=-1)
        probs = jax.nn.softmax(logits, axis=-1)
        p_sel = probs[..., :n_sel * L].reshape(B, H, Q_CHUNK, n_sel, L)
        p_own = probs[..., n_sel * L:]
        return (jnp.einsum('bhqnl,bhqnld->bhqd', p_sel, v_sel)
                + jnp.einsum('bhql,bhld->bhqd', p_own, v_own))

    out = lax.map(chunk, jnp.arange(s_pad // Q_CHUNK))
    out = out.transpose(1, 0, 3, 2, 4).reshape(B, s_pad, H, dh)
    return out[:, :S]


def rotate_pairs(t, cos, sin):
    t2 = t.reshape(t.shape[:-1] + (t.shape[-1] // 2, 2))
    a, b = t2[..., 0], t2[..., 1]
    return jnp.stack([a * cos - b * sin, b * cos + a * sin], axis=-1).reshape(t.shape)


def retention(q, k, v):
    B, S, H, dk = q.shape
    dv = v.shape[-1]
    f32 = jnp.float32
    C = RET_CHUNK
    N = S // C
    pos = jnp.arange(S, dtype=f32)
    theta = 1.0 / (ROT_BASE ** jnp.linspace(0.0, 1.0, dk // 2, dtype=f32))
    ang = pos[:, None] * theta[None, :]
    cos, sin = jnp.cos(ang)[:, None, :], jnp.sin(ang)[:, None, :]
    q = rotate_pairs(q.astype(f32), cos, sin)
    k = rotate_pairs(k.astype(f32), cos, sin) * (dk ** -0.5)
    log_gamma = jnp.log(1.0 - 2.0 ** (-5.0 - jnp.arange(H, dtype=f32)))

    qc = q.reshape(B, N, C, H, dk).transpose(0, 3, 1, 2, 4)
    kc = k.reshape(B, N, C, H, dk).transpose(0, 3, 1, 2, 4)
    vc = v.astype(f32).reshape(B, N, C, H, dv).transpose(0, 3, 1, 2, 4)

    i = jnp.arange(C)
    diff = i[:, None] - i[None, :]
    decay_mask = jnp.where(diff >= 0,
                           jnp.exp(jnp.maximum(diff, 0).astype(f32) * log_gamma[:, None, None]),
                           0.0)
    inner = jnp.einsum('bhncd,bhnmd->bhncm', qc, kc) * decay_mask[None, :, None]
    o_inner = jnp.einsum('bhncm,bhnme->bhnce', inner, vc)

    zeta = jnp.exp((C - 1 - i).astype(f32)[None, :] * log_gamma[:, None])
    kv = jnp.einsum('bhncd,bhnce->bhnde', kc * zeta[None, :, None, :, None], vc)
    chunk_decay = jnp.exp(C * log_gamma)[None, :, None, None]

    def step(R, kv_n):
        return R * chunk_decay + kv_n, R

    _, R_prev = lax.scan(step, jnp.zeros((B, H, dk, dv), f32), kv.transpose(2, 0, 1, 3, 4))
    xi = jnp.exp((i + 1).astype(f32)[None, :] * log_gamma[:, None])
    o_cross = jnp.einsum('bhncd,nbhde->bhnce', qc * xi[None, :, None, :, None], R_prev)
    o = (o_inner + o_cross).reshape(B, H, S, dv)
    o = o * lax.rsqrt(jnp.mean(o * o, axis=-1, keepdims=True) + EPS)
    return o.transpose(0, 2, 1, 3)


def setup_inputs(seed: int = 0) -> dict:
    key = jax.random.key(seed)
    ks = jax.random.split(key, 13)
    f32 = jnp.float32
    nrm = lambda k, shape, s: jax.random.normal(k, shape, f32) * s
    return {
        'x': nrm(ks[0], (BATCH, SEQ, D_MODEL), 1.0),
        'p': nrm(ks[1], (DEPTH, BATCH, SEQ, D_PLE), 1.0),
        'g_mix': 1.0 + nrm(ks[2], (DEPTH, D_MODEL), 0.02),
        'w_in': nrm(ks[3], (DEPTH, D_MODEL, D_IN), D_MODEL ** -0.5),
        'w_a': nrm(ks[4], (DEPTH, D_A, D_MODEL), D_A ** -0.5),
        'w_b': nrm(ks[5], (DEPTH, D_B, D_MODEL), D_B ** -0.5),
        'w_out': nrm(ks[6], (DEPTH, D_MODEL, D_MODEL), D_MODEL ** -0.5),
        'g_ple': 1.0 + nrm(ks[7], (DEPTH, D_MODEL), 0.02),
        'w_ple_gate': nrm(ks[8], (DEPTH, D_MODEL, D_MODEL), D_MODEL ** -0.5),
        'w_ple_proj': nrm(ks[9], (DEPTH, D_PLE, D_MODEL), D_PLE ** -0.5),
        'rel_bias': nrm(ks[10], (N_BUCKETS, N_HEADS_A), 0.5),
        'g_final': 1.0 + nrm(ks[11], (D_MODEL,), 0.02),
    }


def reference(x, p, g_mix, w_in, w_a, w_b, w_out, g_ple, w_ple_gate, w_ple_proj, rel_bias, g_final):
    B, S, _ = x.shape
    split_at = [int(s) for s in np.cumsum(SPLIT_SIZES)[:-1]]
    for i in range(DEPTH):
        h = rms_norm(x, g_mix[i])
        proj = h @ w_in[i]
        q_a, k_a, v_a, z_a, q_b, k_b, v_b, z_b, g_a, g_b = jnp.split(proj, split_at, axis=-1)
        y_a = moba_attention(q_a.reshape(B, S, N_HEADS_A, HEAD_DIM_A),
                             k_a.reshape(B, S, N_HEADS_A, HEAD_DIM_A),
                             v_a.reshape(B, S, N_HEADS_A, HEAD_DIM_A), rel_bias)
        y_a = y_a.reshape(B, S, D_A).astype(x.dtype) * jax.nn.silu(z_a)
        y_b = retention(q_b.reshape(B, S, N_HEADS_B, QK_DIM_B),
                        k_b.reshape(B, S, N_HEADS_B, QK_DIM_B),
                        v_b.reshape(B, S, N_HEADS_B, V_DIM_B))
        y_b = y_b.reshape(B, S, D_B).astype(x.dtype) * jax.nn.silu(z_b)
        merged = jax.nn.sigmoid(g_a) * (y_a @ w_a[i]) + jax.nn.sigmoid(g_b) * (y_b @ w_b[i])
        x = x + merged @ w_out[i]
        hp = rms_norm(x, g_ple[i])
        x = x + jax.nn.sigmoid(hp @ w_ple_gate[i]) * (p[i] @ w_ple_proj[i])
    return rms_norm(x, g_final)
```

```cpp
#include <hip/hip_runtime.h>
#include <math.h>

namespace {
constexpr int NB_ = 4, S_ = 2048, D_ = 2048, M_ = NB_ * S_;
constexpr int DIN_ = 12288, NH_ = 8, DH_ = 128, LB_ = 256, NBLK_ = S_ / LB_;
constexpr int DPLE_ = 256;
constexpr float EPS_ = 1e-6f;

__device__ __forceinline__ float wave_sum(float v) {
#pragma unroll
    for (int o = 32; o > 0; o >>= 1) v += __shfl_xor(v, o);
    return v;
}
__device__ __forceinline__ float wave_max(float v) {
#pragma unroll
    for (int o = 32; o > 0; o >>= 1) v = fmaxf(v, __shfl_xor(v, o));
    return v;
}
__device__ __forceinline__ float block_sum256(float v, float* red) {
    v = wave_sum(v);
    __syncthreads();
    if ((threadIdx.x & 63) == 0) red[threadIdx.x >> 6] = v;
    __syncthreads();
    return red[0] + red[1] + red[2] + red[3];
}
__device__ __forceinline__ float block_max256(float v, float* red) {
    v = wave_max(v);
    __syncthreads();
    if ((threadIdx.x & 63) == 0) red[threadIdx.x >> 6] = v;
    __syncthreads();
    return fmaxf(fmaxf(red[0], red[1]), fmaxf(red[2], red[3]));
}
__device__ __forceinline__ float sigmoidf_(float v) { return 1.0f / (1.0f + expf(-v)); }
__device__ __forceinline__ float siluf_(float v) { return v / (1.0f + expf(-v)); }

__global__ __launch_bounds__(256) void k_rmsnorm(const float* __restrict__ x, const float* __restrict__ g, float* __restrict__ y) {
    __shared__ float red[4];
    const size_t row = blockIdx.x;
    const float* xr = x + row * D_;
    float v[8]; float ss = 0.f;
#pragma unroll
    for (int i = 0; i < 8; ++i) { v[i] = xr[threadIdx.x + 256 * i]; ss += v[i] * v[i]; }
    ss = block_sum256(ss, red);
    const float r = 1.0f / sqrtf(ss / (float)D_ + EPS_);
#pragma unroll
    for (int i = 0; i < 8; ++i) y[row * D_ + threadIdx.x + 256 * i] = v[i] * r * g[threadIdx.x + 256 * i];
}

__global__ __launch_bounds__(256) void k_sgemm(const float* __restrict__ A, int lda, const float* __restrict__ B, int ldb, float* __restrict__ C, int ldc, int K) {
    __shared__ float As[16][132];
    __shared__ float Bs[16][132];
    const int bm = blockIdx.y * 128, bn = blockIdx.x * 128;
    const int tid = threadIdx.x, tx = tid & 15, ty = tid >> 4;
    float acc[8][8];
#pragma unroll
    for (int i = 0; i < 8; ++i)
#pragma unroll
        for (int j = 0; j < 8; ++j) acc[i][j] = 0.f;
    const int ar = tid >> 1, ac = (tid & 1) * 8;
    const int br = tid >> 4, bc = (tid & 15) * 8;
    for (int k0 = 0; k0 < K; k0 += 16) {
        const float4 a0 = *(const float4*)&A[(size_t)(bm + ar) * lda + k0 + ac];
        const float4 a1 = *(const float4*)&A[(size_t)(bm + ar) * lda + k0 + ac + 4];
        const float4 b0 = *(const float4*)&B[(size_t)(k0 + br) * ldb + bn + bc];
        const float4 b1 = *(const float4*)&B[(size_t)(k0 + br) * ldb + bn + bc + 4];
        __syncthreads();
        As[ac + 0][ar] = a0.x; As[ac + 1][ar] = a0.y; As[ac + 2][ar] = a0.z; As[ac + 3][ar] = a0.w;
        As[ac + 4][ar] = a1.x; As[ac + 5][ar] = a1.y; As[ac + 6][ar] = a1.z; As[ac + 7][ar] = a1.w;
        *(float4*)&Bs[br][bc] = b0; *(float4*)&Bs[br][bc + 4] = b1;
        __syncthreads();
#pragma unroll
        for (int kk = 0; kk < 16; ++kk) {
            const float4 x0 = *(const float4*)&As[kk][ty * 8], x1 = *(const float4*)&As[kk][ty * 8 + 4];
            const float4 y0 = *(const float4*)&Bs[kk][tx * 8], y1 = *(const float4*)&Bs[kk][tx * 8 + 4];
            const float a[8] = {x0.x, x0.y, x0.z, x0.w, x1.x, x1.y, x1.z, x1.w};
            const float b[8] = {y0.x, y0.y, y0.z, y0.w, y1.x, y1.y, y1.z, y1.w};
#pragma unroll
            for (int i = 0; i < 8; ++i)
#pragma unroll
                for (int j = 0; j < 8; ++j) acc[i][j] = fmaf(a[i], b[j], acc[i][j]);
        }
    }
#pragma unroll
    for (int i = 0; i < 8; ++i) {
        float* cp = &C[(size_t)(bm + ty * 8 + i) * ldc + bn + tx * 8];
        *(float4*)cp = make_float4(acc[i][0], acc[i][1], acc[i][2], acc[i][3]);
        *(float4*)(cp + 4) = make_float4(acc[i][4], acc[i][5], acc[i][6], acc[i][7]);
    }
}

__global__ __launch_bounds__(128) void k_kmean(const float* __restrict__ P, float* __restrict__ kmean) {
    const int bhn = blockIdx.x;
    const int n = bhn & 7, h = (bhn >> 3) & 7, b = bhn >> 6;
    const int d = threadIdx.x;
    float s = 0.f;
    for (int l = 0; l < LB_; ++l) s += P[(size_t)(b * S_ + n * LB_ + l) * 4096 + 1024 + h * DH_ + d];
    kmean[(size_t)bhn * DH_ + d] = s * (1.0f / LB_);
}

__device__ __forceinline__ int t5_bucket(int n) {
    if (n < 16) return n;
    const float v = logf((float)n / 16.0f) / logf(8.0f) * 16.0f;
    const int l = 16 + (int)v;
    return l < 31 ? l : 31;
}

__global__ __launch_bounds__(256) void k_moba(const float* __restrict__ P, const float* __restrict__ kmean, const float* __restrict__ rel_bias, float* __restrict__ YA) {
    __shared__ float qs[DH_];
    __shared__ float sc[4 * LB_];
    __shared__ float gate[NBLK_];
    __shared__ int sel[4];
    __shared__ float red[4];
    __shared__ float part[2][DH_];
    const int m = blockIdx.x >> 3, h = blockIdx.x & 7;
    const int b = m / S_, s = m % S_, blk = s / LB_;
    const int tid = threadIdx.x, lane = tid & 63, w = tid >> 6;
    if (tid < DH_) qs[tid] = P[(size_t)m * 4096 + h * DH_ + tid];
    __syncthreads();
    for (int n = w; n < NBLK_; n += 4) {
        const float* km = kmean + (size_t)((b * NH_ + h) * NBLK_ + n) * DH_;
        float v = qs[lane] * km[lane] + qs[lane + 64] * km[lane + 64];
        v = wave_sum(v);
        if (lane == 0) gate[n] = v;
    }
    __syncthreads();
    if (tid == 0) {
        bool used[NBLK_];
#pragma unroll
        for (int n = 0; n < NBLK_; ++n) used[n] = false;
#pragma unroll
        for (int t = 0; t < 3; ++t) {
            int best = -1; float bv = -INFINITY;
#pragma unroll
            for (int n = 0; n < NBLK_; ++n) if (n < blk && !used[n] && (best < 0 || gate[n] > bv)) { best = n; bv = gate[n]; }
#pragma unroll
            for (int n = 0; n < NBLK_; ++n) if (n == best) used[n] = true;
            sel[t] = best;
        }
        sel[3] = blk;
    }
    __syncthreads();
    const float scale = 0.08838834764831845f;
    float mx = -INFINITY;
#pragma unroll 1
    for (int seg = 0; seg < 4; ++seg) {
        const int kb = sel[seg];
        float v = -INFINITY;
        if (kb >= 0) {
            const int pos = kb * LB_ + tid;
            if (pos <= s) {
                const float* kr = P + (size_t)(b * S_ + pos) * 4096 + 1024 + h * DH_;
                float dsum = 0.f;
#pragma unroll 8
                for (int d = 0; d < DH_; d += 4) { const float4 kv = *(const float4*)(kr + d); dsum += qs[d] * kv.x + qs[d + 1] * kv.y + qs[d + 2] * kv.z + qs[d + 3] * kv.w; }
                v = dsum * scale + rel_bias[t5_bucket(s - pos) * NH_ + h];
            }
        }
        sc[seg * LB_ + tid] = v;
        mx = fmaxf(mx, v);
    }
    mx = block_max256(mx, red);
    float sum = 0.f;
#pragma unroll
    for (int seg = 0; seg < 4; ++seg) { const float v = sc[seg * LB_ + tid]; const float e = (v == -INFINITY) ? 0.f : expf(v - mx); sc[seg * LB_ + tid] = e; sum += e; }
    sum = block_sum256(sum, red);
    __syncthreads();
    const int d = tid & 127, half = tid >> 7;
    float acc = 0.f;
    for (int e = half * 512; e < half * 512 + 512; ++e) {
        const float pw = sc[e];
        if (pw != 0.f) {
            const int kb = sel[e >> 8];
            const int pos = kb * LB_ + (e & 255);
            acc += pw * P[(size_t)(b * S_ + pos) * 4096 + 2048 + h * DH_ + d];
        }
    }
    part[half][d] = acc;
    __syncthreads();
    if (tid < DH_) {
        const float o = (part[0][tid] + part[1][tid]) / sum;
        const float z = P[(size_t)m * 4096 + 3072 + h * DH_ + tid];
        YA[(size_t)m * 1024 + h * DH_ + tid] = o * siluf_(z);
    }
}

__global__ __launch_bounds__(256) void k_rotary(float* __restrict__ P) {
    const size_t idx = (size_t)blockIdx.x * 256 + threadIdx.x;
    const int j = idx & 63, h = (idx >> 6) & 7; const size_t m = idx >> 9;
    const int s = (int)(m % S_);
    const float theta = 1.0f / powf(10000.0f, (float)j / 63.0f);
    const float ang = (float)s * theta;
    const float cs = cosf(ang), sn = sinf(ang);
    float* q = P + m * 4096 + h * DH_ + 2 * j;
    float* k = P + m * 4096 + 1024 + h * DH_ + 2 * j;
    const float qa = q[0], qb = q[1], ka = k[0], kb = k[1];
    q[0] = qa * cs - qb * sn; q[1] = qb * cs + qa * sn;
    const float ksc = 0.08838834764831845f;
    k[0] = (ka * cs - kb * sn) * ksc; k[1] = (kb * cs + ka * sn) * ksc;
}

__global__ __launch_bounds__(256) void k_retention(const float* __restrict__ P, float* __restrict__ YB) {
    __shared__ float qs[DH_];
    __shared__ float wts[LB_];
    __shared__ float red[4];
    __shared__ float part[2][DH_];
    const int m = blockIdx.x >> 3, h = blockIdx.x & 7;
    const int b = m / S_, s = m % S_;
    const int tid = threadIdx.x;
    if (tid < DH_) qs[tid] = P[(size_t)m * 4096 + h * DH_ + tid];
    __syncthreads();
    const float lg = (float)log(1.0 - exp2(-5.0 - (double)h));
    const int d = tid & 127, half = tid >> 7;
    float acc = 0.f;
    for (int c0 = 0; c0 <= s; c0 += LB_) {
        const int pos = c0 + tid;
        float wv = 0.f;
        if (pos <= s) {
            const float* kr = P + (size_t)(b * S_ + pos) * 4096 + 1024 + h * DH_;
            float dsum = 0.f;
            for (int dd = 0; dd < DH_; dd += 4) { const float4 kv = *(const float4*)(kr + dd); dsum += qs[dd] * kv.x + qs[dd + 1] * kv.y + qs[dd + 2] * kv.z + qs[dd + 3] * kv.w; }
            wv = dsum * expf((float)(s - pos) * lg);
        }
        __syncthreads();
        wts[tid] = wv;
        __syncthreads();
        for (int e = half * 128; e < half * 128 + 128; ++e) {
            const int p2 = c0 + e;
            if (p2 <= s) acc += wts[e] * P[(size_t)(b * S_ + p2) * 4096 + 2048 + h * DH_ + d];
        }
    }
    part[half][d] = acc;
    __syncthreads();
    float o = 0.f;
    if (tid < DH_) o = part[0][tid] + part[1][tid];
    const float ss = block_sum256(o * o, red);
    if (tid < DH_) {
        const float r = 1.0f / sqrtf(ss / (float)DH_ + EPS_);
        const float z = P[(size_t)m * 4096 + 3072 + h * DH_ + tid];
        YB[(size_t)m * 1024 + h * DH_ + tid] = o * r * siluf_(z);
    }
}

__global__ __launch_bounds__(256) void k_merge(const float* __restrict__ G, float* __restrict__ U, const float* __restrict__ V) {
    const size_t idx = (size_t)blockIdx.x * 256 + threadIdx.x;
    const size_t m = idx >> 11; const int n = idx & 2047;
    U[idx] = sigmoidf_(G[m * 4096 + n]) * U[idx] + sigmoidf_(G[m * 4096 + 2048 + n]) * V[idx];
}
__global__ __launch_bounds__(256) void k_add(const float* __restrict__ a, const float* __restrict__ b, float* __restrict__ c) {
    const size_t idx = (size_t)blockIdx.x * 256 + threadIdx.x;
    c[idx] = a[idx] + b[idx];
}
__global__ __launch_bounds__(256) void k_ple(float* __restrict__ x, const float* __restrict__ G, const float* __restrict__ PP) {
    const size_t idx = (size_t)blockIdx.x * 256 + threadIdx.x;
    x[idx] = x[idx] + sigmoidf_(G[idx]) * PP[idx];
}
}

extern "C" void kernel_launch(void* const* d_in, const int* in_sizes, int n_in, void* d_out, int out_size, void* d_ws, size_t ws_size, hipStream_t stream) {
    const float* x = (const float*)d_in[0];
    const float* p = (const float*)d_in[1];
    const float* g_mix = (const float*)d_in[2];
    const float* w_in = (const float*)d_in[3];
    const float* w_a = (const float*)d_in[4];
    const float* w_b = (const float*)d_in[5];
    const float* w_out = (const float*)d_in[6];
    const float* g_ple = (const float*)d_in[7];
    const float* w_pg = (const float*)d_in[8];
    const float* w_pp = (const float*)d_in[9];
    const float* rel_bias = (const float*)d_in[10];
    const float* g_final = (const float*)d_in[11];
    float* out = (float*)d_out;
    float* ws = (float*)d_ws;
    const size_t U1 = (size_t)M_ * 1024;
    float* Hb = ws;
    float* BIG = ws + 2 * U1;
    float* YA = ws + 6 * U1;
    float* YB = ws + 7 * U1;
    float* Ub = ws + 8 * U1;
    float* Vb = ws + 10 * U1;
    float* kmean = out;

    k_rmsnorm<<<M_, 256, 0, stream>>>(x, g_mix, Hb);
    k_sgemm<<<dim3(4096 / 128, M_ / 128), 256, 0, stream>>>(Hb, D_, w_in, DIN_, BIG, 4096, D_);
    k_kmean<<<NB_ * NH_ * NBLK_, 128, 0, stream>>>(BIG, kmean);
    k_moba<<<M_ * NH_, 256, 0, stream>>>(BIG, kmean, rel_bias, YA);
    k_sgemm<<<dim3(4096 / 128, M_ / 128), 256, 0, stream>>>(Hb, D_, w_in + 4096, DIN_, BIG, 4096, D_);
    k_rotary<<<(M_ * NH_ * 64) / 256, 256, 0, stream>>>(BIG);
    k_retention<<<M_ * NH_, 256, 0, stream>>>(BIG, YB);
    k_sgemm<<<dim3(4096 / 128, M_ / 128), 256, 0, stream>>>(Hb, D_, w_in + 8192, DIN_, BIG, 4096, D_);
    k_sgemm<<<dim3(2048 / 128, M_ / 128), 256, 0, stream>>>(YA, 1024, w_a, D_, Ub, D_, 1024);
    k_sgemm<<<dim3(2048 / 128, M_ / 128), 256, 0, stream>>>(YB, 1024, w_b, D_, Vb, D_, 1024);
    k_merge<<<(M_ * D_) / 256, 256, 0, stream>>>(BIG, Ub, Vb);
    k_sgemm<<<dim3(2048 / 128, M_ / 128), 256, 0, stream>>>(Ub, D_, w_out, D_, Vb, D_, D_);
    k_add<<<(M_ * D_) / 256, 256, 0, stream>>>(x, Vb, Hb);
    k_rmsnorm<<<M_, 256, 0, stream>>>(Hb, g_ple, BIG);
    k_sgemm<<<dim3(2048 / 128, M_ / 128), 256, 0, stream>>>(BIG, D_, w_pg, D_, BIG + 2 * U1, D_, D_);
    k_sgemm<<<dim3(2048 / 128, M_ / 128), 256, 0, stream>>>(p, DPLE_, w_pp, D_, Ub, D_, DPLE_);
    k_ple<<<(M_ * D_) / 256, 256, 0, stream>>>(Hb, BIG + 2 * U1, Ub);
    k_rmsnorm<<<M_, 256, 0, stream>>>(Hb, g_final, out);
}
```

```cpp
#include <hip/hip_runtime.h>
#include <hip/hip_cooperative_groups.h>
#include <cstdio>
#include <cstdint>
namespace cg = cooperative_groups;

#define LAS __attribute__((address_space(3)))
typedef unsigned short bf16_t;
typedef short bf16x8 __attribute__((ext_vector_type(8)));
typedef float f32x4 __attribute__((ext_vector_type(4)));
typedef float f32x2 __attribute__((ext_vector_type(2)));
typedef unsigned u32x4 __attribute__((ext_vector_type(4)));
typedef unsigned u32x2 __attribute__((ext_vector_type(2)));

constexpr int NB = 4, SEQ = 2048, DM = 2048, M = NB * SEQ, DIN = 12288, NH = 8, DH = 128, LBLK = 256, DPLE = 256;
constexpr float EPS = 1e-6f, LOG2E = 1.4426950408889634f;
constexpr float QSCALE_A = 0.08838834764831845f * LOG2E;
constexpr float KSCALE_B = 0.08838834764831845f;

constexpr size_t MiB = 1u << 20;
constexpr size_t WS_KMEAN = 64 * 1024;
constexpr size_t WS_CS = 1 * MiB;
constexpr size_t WS_W1T = 2 * MiB;
constexpr size_t WS_WABT = 50 * MiB;
constexpr size_t WS_WOT = 58 * MiB;
constexpr size_t WS_WPGT = 66 * MiB;
constexpr size_t WS_WPPT = 74 * MiB;
constexpr size_t WS_PBF = 75 * MiB;
constexpr size_t WS_SSQ1 = 79 * MiB;
constexpr size_t WS_SSQ2 = 80 * MiB;
constexpr size_t WS_HBF = 82 * MiB;
constexpr size_t WS_Y = 114 * MiB;
constexpr size_t WS_MRG = 146 * MiB;
constexpr size_t WS_PROJ = 178 * MiB;
constexpr size_t WS_G = 306 * MiB;
constexpr size_t WS_PPT = 178 * MiB;
constexpr size_t WS_END = 370 * MiB;
constexpr size_t HM = (size_t)M * 1024;

constexpr int LDS_BYTES = 147456;
constexpr int LDS_MISC = 131072;

__device__ __forceinline__ float bf2f(unsigned short v) { return __uint_as_float((unsigned)v << 16); }
__device__ __forceinline__ unsigned f2bf(float f) { unsigned u = __float_as_uint(f); return (u + 0x7fffu + ((u >> 16) & 1u)) >> 16; }
__device__ __forceinline__ unsigned pk2(float lo, float hi) { return f2bf(lo) | (f2bf(hi) << 16); }
__device__ __forceinline__ float wave_sum(float v) {
#pragma unroll
    for (int o = 1; o < 64; o <<= 1) v += __shfl_xor(v, o);
    return v;
}
__device__ __forceinline__ float wave_max(float v) {
#pragma unroll
    for (int o = 1; o < 64; o <<= 1) v = fmaxf(v, __shfl_xor(v, o));
    return v;
}
__device__ __forceinline__ float fast_sigmoid(float v) { return __builtin_amdgcn_rcpf(1.0f + __builtin_amdgcn_exp2f(-v * LOG2E)); }
#define LDS_WAIT() asm volatile("s_waitcnt lgkmcnt(0)" ::: "memory")
#define OPAQUE_LANE_COORDS() int t__ = threadIdx.x; asm volatile("" : "+v"(t__)); const int wr = t__ >> 8, wc = (t__ >> 6) & 3, fr = t__ & 15, fq = (t__ >> 4) & 3

namespace pg8 {
constexpr int BM = 256, BK = 64, HALF = 128, HTB = HALF * BK * 2, STAGE_BYTES = 8 * HTB, NXCD = 8, WGM = 8;
__host__ __device__ __forceinline__ int lds_byte(int r, int c) { const int st = (r >> 4) * 2 + (c >> 5), rr = r & 15, cc = c & 31, ob = rr * 64 + cc * 2; return st * 1024 + (ob ^ (((ob >> 9) & 1) << 5)); }
__host__ __device__ __forceinline__ void stage_rc(int b, int& R, int& C) { const int st = b / 1024, sb = b % 1024, swz = sb ^ (((sb >> 9) & 1) << 5); R = (st >> 1) * 16 + swz / 64; C = (st & 1) * 32 + (swz % 64) / 2; }
__host__ __device__ __forceinline__ int perm32(int rho) { const int n = rho >> 4, i = rho & 15; return 8 * (i >> 2) + 4 * n + (i & 3); }
struct Unit { int pm, pn; };
struct Gemm { const bf16_t* A; const bf16_t* Bt; int M, N, K; };
struct StaticOrder {
    int nM, nN, nwg, G, c;
    __host__ __device__ void init(int M_, int N_, int G_, int c_) { nM = M_ / BM; nN = N_ / BM; nwg = nM * nN; G = G_; c = c_; }
    __host__ __device__ bool next(int i, Unit& u) const {
        const long L = (long)i * G + c; if (L >= nwg) return false;
        int wgid = (int)L; { const int q = nwg / NXCD, r = nwg % NXCD, xcd = wgid % NXCD, off = wgid / NXCD; wgid = (xcd < r ? xcd * (q + 1) : r * (q + 1) + (xcd - r) * q) + off; }
        const int nig = WGM * nN, gid = wgid / nig, fm = gid * WGM, gsz = (nM - fm) < WGM ? (nM - fm) : WGM;
        u.pm = fm + ((wgid % nig) % gsz); u.pn = (wgid % nig) / gsz; return true;
    }
};
__device__ __forceinline__ unsigned cvt_pk_bf16(float lo, float hi) { unsigned r; asm volatile("v_cvt_pk_bf16_f32 %0, %1, %2" : "=v"(r) : "v"(lo), "v"(hi)); return r; }

template <class Epi, class Sched, bool ALIGN_EPI, bool SP2>
__device__ __forceinline__ void gemm_phase(LAS unsigned char* lds, const Gemm g, const Sched& S, const Epi& E) {
    int tid = threadIdx.x; asm volatile("" : "+v"(tid));
    const int wid = __builtin_amdgcn_readfirstlane(tid >> 6), lane = tid & 63, wr = wid >> 2, wc = wid & 3, fr = lane & 15, fq = lane >> 4;
    const int K = g.K, nt = K / BK;
    unsigned voffA[2], voffB[2];
#pragma unroll
    for (int i = 0; i < 2; ++i) { int R, C; stage_rc(tid * 16 + i * 8192, R, C); const int Rb = Epi::PERM ? ((R & ~31) + perm32(R & 31)) : R;
        voffA[i] = (unsigned)(R * K + C) * 2u; voffB[i] = (unsigned)(Rb * K + C) * 2u; }
    const size_t kstep = (size_t)(BK * 2);
    const size_t hstep = (size_t)HALF * K * 2;
    const size_t tstep = 2 * hstep;
    const unsigned ldsw = (unsigned)wid * 1024u;
    const int aoff = lds_byte(wr * 64 + fr, fq * 8), boff = lds_byte(wc * 32 + fr, fq * 8);
#define PG8_SA(b, h) (((b) * 2 + (h)) * HTB)
#define PG8_SB(b, h) ((4 + (b) * 2 + (h)) * HTB)
#define PG8_STAGE(bufoff, gbase, voff) do { _Pragma("unroll") for (int _i = 0; _i < 2; ++_i) \
        __builtin_amdgcn_global_load_lds((const unsigned*)((const char*)(gbase) + (voff)[_i]), (LAS unsigned*)(lds + (bufoff) + ldsw + _i * 8192), 16, 0, 0); } while (0)
#define PG8_LDA(dst, b, h) do { _Pragma("unroll") for (int m = 0; m < 4; ++m) _Pragma("unroll") for (int k = 0; k < 2; ++k) dst[m][k] = *(const LAS bf16x8*)(lds + PG8_SA(b, h) + aoff + m * 2048 + k * 1024); } while (0)
#define PG8_LDB(dst, b, h) do { _Pragma("unroll") for (int n = 0; n < 2; ++n) _Pragma("unroll") for (int k = 0; k < 2; ++k) dst[n][k] = *(const LAS bf16x8*)(lds + PG8_SB(b, h) + boff + n * 2048 + k * 1024); } while (0)
#define PG8_MMA(ai, bj, At, Bt) do { __builtin_amdgcn_s_setprio(1); _Pragma("unroll") for (int m = 0; m < 4; ++m) _Pragma("unroll") for (int n = 0; n < 2; ++n) _Pragma("unroll") for (int k = 0; k < 2; ++k) \
        acc[ai][bj][m][n] = __builtin_amdgcn_mfma_f32_16x16x32_bf16(Bt[n][k], At[m][k], acc[ai][bj][m][n], 0, 0, 0); __builtin_amdgcn_s_setprio(0); } while (0)
#define PG8_WAIT_V(n) asm volatile("s_waitcnt vmcnt(" #n ")" ::: "memory")
#define PG8_WAIT_L(n) asm volatile("s_waitcnt lgkmcnt(" #n ")" ::: "memory")
#define PG8_BAR __builtin_amdgcn_s_barrier()
#define PG8_SCHED __builtin_amdgcn_sched_barrier(0)
    Unit cur, nxt; int ui = 0;
    if (!S.next(0, cur)) return;
    f32x4 acc[2][2][4][2];
#pragma unroll
    for (int a = 0; a < 2; ++a)
#pragma unroll
        for (int b = 0; b < 2; ++b)
#pragma unroll
            for (int m = 0; m < 4; ++m)
#pragma unroll
                for (int n = 0; n < 2; ++n) acc[a][b][m][n] = (f32x4){0.f, 0.f, 0.f, 0.f};
    bf16x8 At[4][2], B0[2][2], B1[2][2];
    const char* cA = (const char*)g.A + (size_t)cur.pm * tstep; const char* cB = (const char*)g.Bt + (size_t)cur.pn * tstep;
    if constexpr (SP2) {
        PG8_STAGE(PG8_SB(0, 0), cB, voffB); PG8_STAGE(PG8_SB(0, 1), cB + hstep, voffB); PG8_STAGE(PG8_SA(0, 0), cA, voffA); PG8_STAGE(PG8_SA(0, 1), cA + hstep, voffA);
        if (wr == 1) PG8_BAR;
        PG8_WAIT_V(2); PG8_BAR;
        PG8_STAGE(PG8_SB(1, 0), cB + kstep, voffB); PG8_STAGE(PG8_SA(1, 0), cA + kstep, voffA); PG8_STAGE(PG8_SB(1, 1), cB + hstep + kstep, voffB);
        PG8_WAIT_V(6); PG8_BAR;
    } else {
        PG8_STAGE(PG8_SB(0, 0), cB, voffB); PG8_STAGE(PG8_SA(0, 0), cA, voffA); PG8_STAGE(PG8_SB(0, 1), cB + hstep, voffB); PG8_STAGE(PG8_SA(0, 1), cA + hstep, voffA);
        if (wr == 1) PG8_BAR;
        PG8_WAIT_V(4); PG8_BAR;
        PG8_STAGE(PG8_SB(1, 0), cB + kstep, voffB); PG8_STAGE(PG8_SA(1, 0), cA + kstep, voffA); PG8_STAGE(PG8_SB(1, 1), cB + hstep + kstep, voffB);
        PG8_WAIT_V(6); PG8_BAR;
    }
    for (;;) {
        const bool has_next = S.next(ui + 1, nxt);
        const char* nA = has_next ? (const char*)g.A + (size_t)nxt.pm * tstep : cA; const char* nB = has_next ? (const char*)g.Bt + (size_t)nxt.pn * tstep : cB;
        for (int t = 0; t < nt; t += 2) {
            const bool last = (t == nt - 2);
            const char* a1 = cA + (size_t)(t + 1) * kstep;
            const char* a2 = last ? nA : cA + (size_t)(t + 2) * kstep; const char* b2 = last ? nB : cB + (size_t)(t + 2) * kstep;
            const char* a3 = a2 + kstep; const char* b3 = b2 + kstep;
            if constexpr (Epi::MID) { if (t == (nt >> 1)) E.mid(acc, cur, wr, wc, fr, fq); }
            if constexpr (SP2) {
            PG8_LDB(B0, 0, 0); PG8_LDB(B1, 0, 1); PG8_SCHED; PG8_LDA(At, 0, 0); PG8_STAGE(PG8_SA(1, 1), a1 + hstep, voffA);
            PG8_WAIT_V(8); PG8_WAIT_L(0); PG8_BAR; PG8_MMA(0, 0, At, B0); PG8_MMA(0, 1, At, B1); PG8_BAR; PG8_SCHED;
            PG8_LDA(At, 0, 1); PG8_STAGE(PG8_SB(0, 0), b2, voffB); PG8_STAGE(PG8_SB(0, 1), b2 + hstep, voffB); PG8_STAGE(PG8_SA(0, 0), a2, voffA);
            PG8_WAIT_V(8); PG8_WAIT_L(0); PG8_BAR; PG8_MMA(1, 0, At, B0); PG8_MMA(1, 1, At, B1); PG8_BAR; PG8_SCHED;
            PG8_LDB(B0, 1, 0); PG8_LDB(B1, 1, 1); PG8_SCHED; PG8_LDA(At, 1, 0); PG8_STAGE(PG8_SA(0, 1), a2 + hstep, voffA);
            PG8_WAIT_V(8); PG8_WAIT_L(0); PG8_BAR; PG8_MMA(0, 0, At, B0); PG8_MMA(0, 1, At, B1); PG8_BAR; PG8_SCHED;
            PG8_LDA(At, 1, 1); PG8_STAGE(PG8_SB(1, 0), b3, voffB); PG8_STAGE(PG8_SB(1, 1), b3 + hstep, voffB); PG8_STAGE(PG8_SA(1, 0), a3, voffA);
            PG8_WAIT_V(8); PG8_WAIT_L(0); PG8_BAR; PG8_MMA(1, 0, At, B0); PG8_MMA(1, 1, At, B1); PG8_BAR; PG8_SCHED;
            } else {
            PG8_LDB(B0, 0, 0); PG8_SCHED; PG8_LDA(At, 0, 0); PG8_STAGE(PG8_SA(1, 1), a1 + hstep, voffA);
            PG8_WAIT_L(8); PG8_BAR; PG8_WAIT_L(0); PG8_MMA(0, 0, At, B0); PG8_BAR; PG8_SCHED;
            PG8_LDB(B1, 0, 1); PG8_STAGE(PG8_SB(0, 0), b2, voffB);
            PG8_BAR; PG8_WAIT_L(0); PG8_MMA(0, 1, At, B1); PG8_BAR;
            PG8_LDA(At, 0, 1); PG8_STAGE(PG8_SA(0, 0), a2, voffA);
            PG8_BAR; PG8_WAIT_L(0); PG8_MMA(1, 0, At, B0); PG8_BAR; PG8_SCHED;
            PG8_STAGE(PG8_SB(0, 1), b2 + hstep, voffB);
            PG8_WAIT_V(6); PG8_BAR; PG8_MMA(1, 1, At, B1); PG8_BAR;
            PG8_LDB(B0, 1, 0); PG8_SCHED; PG8_LDA(At, 1, 0); PG8_STAGE(PG8_SA(0, 1), a2 + hstep, voffA);
            PG8_WAIT_L(8); PG8_BAR; PG8_WAIT_L(0); PG8_MMA(0, 0, At, B0); PG8_BAR; PG8_SCHED;
            PG8_LDB(B1, 1, 1); PG8_STAGE(PG8_SB(1, 0), b3, voffB);
            PG8_BAR; PG8_WAIT_L(0); PG8_MMA(0, 1, At, B1); PG8_BAR;
            PG8_LDA(At, 1, 1); PG8_STAGE(PG8_SA(1, 0), a3, voffA);
            PG8_BAR; PG8_WAIT_L(0); PG8_MMA(1, 0, At, B0); PG8_BAR; PG8_SCHED;
            PG8_STAGE(PG8_SB(1, 1), b3 + hstep, voffB);
            PG8_WAIT_V(6); PG8_BAR; PG8_MMA(1, 1, At, B1); PG8_BAR;
            }
        }
        if constexpr (ALIGN_EPI) { if (wr == 0) PG8_BAR; }
        E(acc, cur, wr, wc, fr, fq);
        if (!has_next) break;
#pragma unroll
        for (int a = 0; a < 2; ++a)
#pragma unroll
            for (int b = 0; b < 2; ++b)
#pragma unroll
                for (int m = 0; m < 4; ++m)
#pragma unroll
                    for (int n = 0; n < 2; ++n) acc[a][b][m][n] = (f32x4){0.f, 0.f, 0.f, 0.f};
        cur = nxt; cA = nA; cB = nB; ++ui;
        if constexpr (ALIGN_EPI) { if (wr == 1) PG8_BAR; }
    }
    PG8_WAIT_V(0);
    if constexpr (!ALIGN_EPI) { if (wr == 0) PG8_BAR; }
    PG8_BAR;
#undef PG8_SA
#undef PG8_SB
#undef PG8_STAGE
#undef PG8_LDA
#undef PG8_LDB
#undef PG8_MMA
#undef PG8_WAIT_V
#undef PG8_WAIT_L
#undef PG8_BAR
#undef PG8_SCHED
}
}

using pg8::Unit;
typedef f32x4 Acc[2][2][4][2];

struct EpiProj {
    static constexpr bool PERM = true, MID = false;
    bf16_t* proj; bf16_t* G; float* kmean; const float* cs;
    __device__ __forceinline__ void operator()(const Acc& acc, const Unit& u, int, int, int, int) const {
        OPAQUE_LANE_COORDS();
        const int seg = u.pn >> 2;
        if (seg >= 8) {
            const int row0 = u.pm * 256 + wr * 64 + fr, col0 = (u.pn - 32) * 256 + wc * 32 + 8 * fq;
#pragma unroll
            for (int ai = 0; ai < 2; ++ai)
#pragma unroll
                for (int m = 0; m < 4; ++m) { bf16_t* rowp = G + (size_t)(row0 + ai * 128 + m * 16) * 4096 + col0;
#pragma unroll
                    for (int bj = 0; bj < 2; ++bj) { const f32x4 v0 = acc[ai][bj][m][0], v1 = acc[ai][bj][m][1];
                        u32x4 w; w.x = pg8::cvt_pk_bf16(v0[0], v0[1]); w.y = pg8::cvt_pk_bf16(v0[2], v0[3]); w.z = pg8::cvt_pk_bf16(v1[0], v1[1]); w.w = pg8::cvt_pk_bf16(v1[2], v1[3]);
                        *(u32x4*)(rowp + bj * 128) = w; } }
            return;
        }
        bf16_t* base = proj + (size_t)seg * HM;
        const int b = u.pm >> 3, s0 = (u.pm & 7) * 256 + wr * 64 + fr, hq = (u.pn & 3) * 2, d0 = wc * 32 + 8 * fq;
        const bool rot = (seg == 4) || (seg == 5);
        float cs_[2][8];
#pragma unroll
        for (int bj = 0; bj < 2; ++bj)
#pragma unroll
            for (int i = 0; i < 8; ++i) cs_[bj][i] = 0.f;
#pragma unroll
        for (int ai = 0; ai < 2; ++ai)
#pragma unroll
            for (int m = 0; m < 4; ++m) {
                const int s = s0 + ai * 128 + m * 16;
                f32x4 c4 = (f32x4){1.f, 1.f, 1.f, 1.f}, s4 = (f32x4){0.f, 0.f, 0.f, 0.f};
                if (rot) { c4 = *(const f32x4*)(cs + (size_t)s * 64 + (d0 >> 1)); s4 = *(const f32x4*)(cs + (size_t)SEQ * 64 + (size_t)s * 64 + (d0 >> 1)); }
#pragma unroll
                for (int bj = 0; bj < 2; ++bj) {
                    f32x4 v0 = acc[ai][bj][m][0], v1 = acc[ai][bj][m][1];
                    if (seg == 0) { v0 = v0 * QSCALE_A; v1 = v1 * QSCALE_A; }
                    else if (seg == 1) {
#pragma unroll
                        for (int i = 0; i < 4; ++i) { cs_[bj][i] += v0[i]; cs_[bj][4 + i] += v1[i]; } }
                    else if (seg == 3 || seg == 7) {
#pragma unroll
                        for (int i = 0; i < 4; ++i) { v0[i] = v0[i] * fast_sigmoid(v0[i]); v1[i] = v1[i] * fast_sigmoid(v1[i]); } }
                    else if (rot) {
                        const float sc = (seg == 5) ? KSCALE_B : 1.0f;
                        f32x4 r0, r1;
                        r0[0] = (v0[0] * c4[0] - v0[1] * s4[0]) * sc; r0[1] = (v0[1] * c4[0] + v0[0] * s4[0]) * sc;
                        r0[2] = (v0[2] * c4[1] - v0[3] * s4[1]) * sc; r0[3] = (v0[3] * c4[1] + v0[2] * s4[1]) * sc;
                        r1[0] = (v1[0] * c4[2] - v1[1] * s4[2]) * sc; r1[1] = (v1[1] * c4[2] + v1[0] * s4[2]) * sc;
                        r1[2] = (v1[2] * c4[3] - v1[3] * s4[3]) * sc; r1[3] = (v1[3] * c4[3] + v1[2] * s4[3]) * sc;
                        v0 = r0; v1 = r1; }
                    u32x4 w; w.x = pg8::cvt_pk_bf16(v0[0], v0[1]); w.y = pg8::cvt_pk_bf16(v0[2], v0[3]); w.z = pg8::cvt_pk_bf16(v1[0], v1[1]); w.w = pg8::cvt_pk_bf16(v1[2], v1[3]);
                    *(u32x4*)(base + ((size_t)((b * 8 + hq + bj) * SEQ + s)) * 128 + d0) = w;
                }
            }
        if (seg == 1) {
#pragma unroll
            for (int bj = 0; bj < 2; ++bj)
#pragma unroll
                for (int i = 0; i < 8; ++i) { float v = cs_[bj][i]; v += __shfl_xor(v, 1); v += __shfl_xor(v, 2); v += __shfl_xor(v, 4); v += __shfl_xor(v, 8);
                    if (fr == 0) __hip_atomic_fetch_add(kmean + (size_t)u.pm * 1024 + (hq + bj) * 128 + d0 + i, v, __ATOMIC_RELAXED, __HIP_MEMORY_SCOPE_AGENT); }
        }
    }
};

struct EpiMerge {
    static constexpr bool PERM = true, MID = true;
    const bf16_t* G; bf16_t* out;
    __device__ __forceinline__ void mid(Acc& acc, const Unit& u, int, int, int, int) const {
        OPAQUE_LANE_COORDS();
        const int row0 = u.pm * 256 + wr * 64 + fr, col0 = u.pn * 256 + wc * 32 + 8 * fq;
#pragma unroll
        for (int ai = 0; ai < 2; ++ai)
#pragma unroll
            for (int m = 0; m < 4; ++m) { const bf16_t* gp = G + (size_t)(row0 + ai * 128 + m * 16) * 4096 + col0;
#pragma unroll
                for (int bj = 0; bj < 2; ++bj) { const u32x4 ga = *(const u32x4*)(gp + bj * 128), gb = *(const u32x4*)(gp + 2048 + bj * 128);
#pragma unroll
                    for (int i = 0; i < 4; ++i) {
                        const float a0 = __uint_as_float(ga[i] << 16), a1 = __uint_as_float(ga[i] & 0xffff0000u), b0 = __uint_as_float(gb[i] << 16), b1 = __uint_as_float(gb[i] & 0xffff0000u);
                        const float r0 = (1.0f + __builtin_amdgcn_exp2f(-b0 * LOG2E)) * __builtin_amdgcn_rcpf(1.0f + __builtin_amdgcn_exp2f(-a0 * LOG2E));
                        const float r1 = (1.0f + __builtin_amdgcn_exp2f(-b1 * LOG2E)) * __builtin_amdgcn_rcpf(1.0f + __builtin_amdgcn_exp2f(-a1 * LOG2E));
                        acc[ai][bj][m][i >> 1][(i & 1) * 2] *= r0; acc[ai][bj][m][i >> 1][(i & 1) * 2 + 1] *= r1; } } }
    }
    __device__ __forceinline__ void operator()(const Acc& acc, const Unit& u, int, int, int, int) const {
        OPAQUE_LANE_COORDS();
        const int row0 = u.pm * 256 + wr * 64 + fr, col0 = u.pn * 256 + wc * 32 + 8 * fq;
#pragma unroll
        for (int ai = 0; ai < 2; ++ai)
#pragma unroll
            for (int m = 0; m < 4; ++m) { const size_t row = (size_t)(row0 + ai * 128 + m * 16);
#pragma unroll
                for (int bj = 0; bj < 2; ++bj) { const u32x4 gb = *(const u32x4*)(G + row * 4096 + 2048 + col0 + bj * 128);
                    float o[8];
#pragma unroll
                    for (int i = 0; i < 4; ++i) { const float b0 = __uint_as_float(gb[i] << 16), b1 = __uint_as_float(gb[i] & 0xffff0000u);
                        o[2 * i] = acc[ai][bj][m][i >> 1][(i & 1) * 2] * fast_sigmoid(b0); o[2 * i + 1] = acc[ai][bj][m][i >> 1][(i & 1) * 2 + 1] * fast_sigmoid(b1); }
                    u32x4 w; w.x = pg8::cvt_pk_bf16(o[0], o[1]); w.y = pg8::cvt_pk_bf16(o[2], o[3]); w.z = pg8::cvt_pk_bf16(o[4], o[5]); w.w = pg8::cvt_pk_bf16(o[6], o[7]);
                    *(u32x4*)(out + row * 2048 + col0 + bj * 128) = w; } }
    }
};

struct EpiX1 {
    static constexpr bool PERM = false, MID = false;
    const float* x; float* x1; bf16_t* x1bf; float* ssq;
    __device__ __forceinline__ void operator()(const Acc& acc, const Unit& u, int, int, int, int) const {
        OPAQUE_LANE_COORDS();
        const int row0 = u.pm * 256 + wr * 64 + fr, col0 = u.pn * 256 + wc * 32 + 4 * fq;
#pragma unroll
        for (int ai = 0; ai < 2; ++ai)
#pragma unroll
            for (int m = 0; m < 4; ++m) { const size_t row = (size_t)(row0 + ai * 128 + m * 16); float ss = 0.f;
#pragma unroll
                for (int bj = 0; bj < 2; ++bj)
#pragma unroll
                    for (int n = 0; n < 2; ++n) { const size_t off = row * 2048 + col0 + bj * 128 + n * 16;
                        const f32x4 o = *(const f32x4*)(x + off) + acc[ai][bj][m][n];
                        *(f32x4*)(x1 + off) = o;
                        u32x2 w; w.x = pg8::cvt_pk_bf16(o[0], o[1]); w.y = pg8::cvt_pk_bf16(o[2], o[3]); *(u32x2*)(x1bf + off) = w;
                        ss += (o[0] * o[0] + o[1] * o[1]) + (o[2] * o[2] + o[3] * o[3]); }
                ss += __shfl_xor(ss, 16); ss += __shfl_xor(ss, 32);
                if (fq == 0) ssq[row * 32 + u.pn * 4 + wc] = ss; }
    }
};
struct EpiPP {
    static constexpr bool PERM = false, MID = false;
    float* pp;
    __device__ __forceinline__ void operator()(const Acc& acc, const Unit& u, int, int, int, int) const {
        OPAQUE_LANE_COORDS();
        const int row0 = u.pm * 256 + wr * 64 + fr, col0 = u.pn * 256 + wc * 32 + 4 * fq;
#pragma unroll
        for (int ai = 0; ai < 2; ++ai)
#pragma unroll
            for (int m = 0; m < 4; ++m) { const size_t row = (size_t)(row0 + ai * 128 + m * 16);
#pragma unroll
                for (int bj = 0; bj < 2; ++bj)
#pragma unroll
                    for (int n = 0; n < 2; ++n) *(f32x4*)(pp + row * 2048 + col0 + bj * 128 + n * 16) = acc[ai][bj][m][n]; }
    }
};
struct EpiX2 {
    static constexpr bool PERM = false, MID = false;
    const float* pp; float* x1; float* ssq; const LAS float* rstd;
    __device__ __forceinline__ void operator()(const Acc& acc, const Unit& u, int, int, int, int) const {
        OPAQUE_LANE_COORDS();
        const int row0 = u.pm * 256 + wr * 64 + fr, col0 = u.pn * 256 + wc * 32 + 4 * fq;
#pragma unroll
        for (int ai = 0; ai < 2; ++ai)
#pragma unroll
            for (int m = 0; m < 4; ++m) { const size_t row = (size_t)(row0 + ai * 128 + m * 16); float ss = 0.f;
                const float rs = rstd[ai * 128 + wr * 64 + m * 16 + fr];
#pragma unroll
                for (int bj = 0; bj < 2; ++bj)
#pragma unroll
                    for (int n = 0; n < 2; ++n) { const size_t off = row * 2048 + col0 + bj * 128 + n * 16;
                        const f32x4 pv = *(const f32x4*)(pp + off), xv = *(const f32x4*)(x1 + off), a = acc[ai][bj][m][n];
                        f32x4 o;
#pragma unroll
                        for (int i = 0; i < 4; ++i) o[i] = xv[i] + fast_sigmoid(a[i] * rs) * pv[i];
                        *(f32x4*)(x1 + off) = o;
                        ss += (o[0] * o[0] + o[1] * o[1]) + (o[2] * o[2] + o[3] * o[3]); }
                ss += __shfl_xor(ss, 16); ss += __shfl_xor(ss, 32);
                if (fq == 0) ssq[row * 32 + u.pn * 4 + wc] = ss; }
    }
};

struct Args { const float* in[12]; float* out; unsigned char* ws; };

__device__ __forceinline__ void p0_transpose_item(const float* W, int N, bf16_t* WT, int ldt, int coff, const float* sc, LAS float* scr, int item, int lane) {
    const int nblk = N / 32, kb = item / nblk, nb = item % nblk, k0 = 64 * kb, n0 = 32 * nb;
#pragma unroll 8
    for (int i = 0; i < 32; ++i) { const int kk = 2 * i + (lane >> 5); float v = W[(size_t)(k0 + kk) * N + n0 + (lane & 31)]; if (sc) v *= sc[k0 + kk]; scr[kk * 33 + (lane & 31)] = v; }
    LDS_WAIT();
    const int c = lane & 7;
#pragma unroll
    for (int j = 0; j < 4; ++j) { const int n = (lane >> 3) + 8 * j; const LAS float* s = scr + (8 * c) * 33 + n;
        u32x4 o; o.x = pk2(s[0 * 33], s[1 * 33]); o.y = pk2(s[2 * 33], s[3 * 33]); o.z = pk2(s[4 * 33], s[5 * 33]); o.w = pk2(s[6 * 33], s[7 * 33]);
        *(u32x4*)(WT + (size_t)(n0 + n) * ldt + coff + k0 + 8 * c) = o; }
    LDS_WAIT();
}
__device__ __forceinline__ void p0_prologue(const Args& a, LAS unsigned char* lds, int wave, int lane, int G) {
    unsigned char* ws = a.ws;
    LAS float* scr = (LAS float*)(lds + wave * 16384);
    const int gw = blockIdx.x * 8 + wave, NGW = G * 8;
    constexpr int I_IN = (DM / 64) * (DIN / 32), I_A = (1024 / 64) * (DM / 32), I_O = (DM / 64) * (DM / 32), I_PP = (DPLE / 64) * (DM / 32);
    constexpr int NITEMS = I_IN + 2 * I_A + 2 * I_O + I_PP;
    for (int it = gw; it < NITEMS; it += NGW) {
        int r = it;
        if (r < I_IN) { p0_transpose_item(a.in[3], DIN, (bf16_t*)(ws + WS_W1T), DM, 0, nullptr, scr, r, lane); continue; } r -= I_IN;
        if (r < I_A) { p0_transpose_item(a.in[4], DM, (bf16_t*)(ws + WS_WABT), DM, 0, nullptr, scr, r, lane); continue; } r -= I_A;
        if (r < I_A) { p0_transpose_item(a.in[5], DM, (bf16_t*)(ws + WS_WABT), DM, 1024, nullptr, scr, r, lane); continue; } r -= I_A;
        if (r < I_O) { p0_transpose_item(a.in[6], DM, (bf16_t*)(ws + WS_WOT), DM, 0, nullptr, scr, r, lane); continue; } r -= I_O;
        if (r < I_O) { p0_transpose_item(a.in[8], DM, (bf16_t*)(ws + WS_WPGT), DM, 0, a.in[7], scr, r, lane); continue; } r -= I_O;
        p0_transpose_item(a.in[9], DM, (bf16_t*)(ws + WS_WPPT), DPLE, 0, nullptr, scr, r, lane);
    }
    const float* x = a.in[0]; const float* p = a.in[1]; const float* g = a.in[2];
    bf16_t* hb = (bf16_t*)(ws + WS_HBF); bf16_t* pb = (bf16_t*)(ws + WS_PBF);
    for (int m = gw; m < M; m += NGW) {
        const f32x4* xr = (const f32x4*)(x + (size_t)m * DM) + lane;
        f32x4 v[8]; float ss = 0.f;
#pragma unroll
        for (int j = 0; j < 8; ++j) { v[j] = xr[64 * j]; ss += (v[j][0] * v[j][0] + v[j][1] * v[j][1]) + (v[j][2] * v[j][2] + v[j][3] * v[j][3]); }
        const float rstd = 1.0f / sqrtf(wave_sum(ss) * (1.0f / DM) + EPS);
        u32x2* o8 = (u32x2*)(hb + (size_t)m * DM) + lane;
#pragma unroll
        for (int j = 0; j < 8; ++j) { const f32x4 gv = ((const f32x4*)g)[lane + 64 * j]; u32x2 w; w.x = pk2(v[j][0] * rstd * gv[0], v[j][1] * rstd * gv[1]); w.y = pk2(v[j][2] * rstd * gv[2], v[j][3] * rstd * gv[3]); o8[64 * j] = w; }
        const f32x4 pv = ((const f32x4*)(p + (size_t)m * DPLE))[lane];
        u32x2 w; w.x = pk2(pv[0], pv[1]); w.y = pk2(pv[2], pv[3]); ((u32x2*)(pb + (size_t)m * DPLE))[lane] = w;
    }
    float* cs = (float*)(ws + WS_CS);
    for (int s = gw; s < SEQ; s += NGW) {
        const float theta = 1.0f / powf(10000.0f, (float)lane / 63.0f);
        const float ang = (float)s * theta;
        cs[(size_t)s * 64 + lane] = cosf(ang); cs[(size_t)SEQ * 64 + (size_t)s * 64 + lane] = sinf(ang);
    }
    float* km = (float*)(ws + WS_KMEAN);
    for (int i = gw * 64 + lane; i < 32 * 1024; i += NGW * 64) km[i] = 0.f;
}

__device__ __forceinline__ int t5_bucket(int n) {
    if (n < 16) return n;
    const float v = logf((float)n / 16.0f) / logf(8.0f) * 16.0f;
    const int l = 16 + (int)v;
    return l < 31 ? l : 31;
}
__device__ __forceinline__ float dot_q_krow(const LAS float* qs, const bf16_t* krow) {
    float d = 0.f;
#pragma unroll 4
    for (int c = 0; c < 16; ++c) {
        const u32x4 kk = ((const u32x4*)krow)[c];
        const f32x4 qa = *(const LAS f32x4*)(qs + 8 * c), qb = *(const LAS f32x4*)(qs + 8 * c + 4);
        d += qa[0] * __uint_as_float(kk[0] << 16) + qa[1] * __uint_as_float(kk[0] & 0xffff0000u) + qa[2] * __uint_as_float(kk[1] << 16) + qa[3] * __uint_as_float(kk[1] & 0xffff0000u)
           + qb[0] * __uint_as_float(kk[2] << 16) + qb[1] * __uint_as_float(kk[2] & 0xffff0000u) + qb[2] * __uint_as_float(kk[3] << 16) + qb[3] * __uint_as_float(kk[3] & 0xffff0000u);
    }
    return d;
}
__device__ __forceinline__ void p2_simple(const Args& a, LAS unsigned char* lds, int tid, int wave, int lane, int G) {
    unsigned char* ws = a.ws;
    const bf16_t* QA = (const bf16_t*)(ws + WS_PROJ); const bf16_t* KA = QA + HM; const bf16_t* VA = QA + 2 * HM; const bf16_t* ZA = QA + 3 * HM;
    const bf16_t* QB = QA + 4 * HM; const bf16_t* KB = QA + 5 * HM; const bf16_t* VB = QA + 6 * HM; const bf16_t* ZB = QA + 7 * HM;
    const float* kmean = (const float*)(ws + WS_KMEAN);
    bf16_t* Y = (bf16_t*)(ws + WS_Y);
    const float* rel_bias = a.in[10];
    LAS float* bt = (LAS float*)(lds + LDS_MISC + 2048);
    for (int i = tid; i < 8 * 129; i += 512) { const int h = i / 129, d = i % 129; bt[i] = rel_bias[t5_bucket(d) * NH + h] * LOG2E; }
    __syncthreads();
    LAS float* qs = (LAS float*)(lds + wave * 8192);
    LAS float* ps = qs + 128;
    const int gw = blockIdx.x * 8 + wave, NGW = G * 8;
    const float NEG = -__builtin_inff();
    for (int it = gw; it < M * NH; it += NGW) {
        const int h = it & 7, m = it >> 3, b = m >> 11, s = m & 2047, n = s >> 8;
        const size_t hb = (size_t)(b * 8 + h) * SEQ;
        const unsigned qq = ((const unsigned*)(QA + (hb + s) * 128))[lane];
        const float q0 = __uint_as_float(qq << 16), q1 = __uint_as_float(qq & 0xffff0000u);
        LDS_WAIT();
        qs[2 * lane] = q0; qs[2 * lane + 1] = q1;
        float gate[8];
#pragma unroll
        for (int j = 0; j < 8; ++j) {
            gate[j] = NEG;
            if (j < n) { const float* km = kmean + (size_t)(b * 8 + j) * 1024 + h * 128; gate[j] = wave_sum(q0 * km[2 * lane] + q1 * km[2 * lane + 1]); }
        }
        int sel[4]; unsigned used = 0u;
#pragma unroll
        for (int t = 0; t < 3; ++t) { int best = -1; float bv = NEG;
#pragma unroll
            for (int j = 0; j < 8; ++j) if (j < n && !((used >> j) & 1u) && (best < 0 || gate[j] > bv)) { best = j; bv = gate[j]; }
            if (best >= 0) used |= 1u << best;
            sel[t] = best; }
        sel[3] = n;
        LDS_WAIT();
        float mx = NEG;
#pragma unroll
        for (int seg = 0; seg < 4; ++seg) {
            const int blk = sel[seg];
#pragma unroll 1
            for (int i = 0; i < 4; ++i) {
                const int key = blk * 256 + i * 64 + lane; float sc = NEG;
                if (blk >= 0 && key <= s) { const int dist = s - key; sc = dot_q_krow(qs, KA + (hb + key) * 128) + bt[h * 129 + (dist < 128 ? dist : 128)]; }
                ps[seg * 256 + i * 64 + lane] = sc; mx = fmaxf(mx, sc);
            }
        }
        mx = wave_max(mx);
        float sum = 0.f;
#pragma unroll 1
        for (int i = 0; i < 16; ++i) { const float sc = ps[i * 64 + lane]; const float e = (sc == NEG) ? 0.f : __builtin_amdgcn_exp2f(sc - mx); ps[i * 64 + lane] = e; sum += e; }
        sum = wave_sum(sum);
        LDS_WAIT();
        float a0 = 0.f, a1 = 0.f;
#pragma unroll
        for (int seg = 0; seg < 4; ++seg) {
            const int blk = sel[seg];
            if (blk >= 0) {
                const int kmax = (s - blk * 256) < 255 ? (s - blk * 256) : 255;
                const unsigned* vp = (const unsigned*)(VA + (hb + (size_t)blk * 256) * 128) + lane;
#pragma unroll 4
                for (int e = 0; e <= kmax; ++e) { const float pw = ps[seg * 256 + e]; const unsigned vv = vp[(size_t)e * 64];
                    a0 += pw * __uint_as_float(vv << 16); a1 += pw * __uint_as_float(vv & 0xffff0000u); }
            }
        }
        const unsigned zz = ((const unsigned*)(ZA + (hb + s) * 128))[lane];
        const float inv = 1.0f / sum;
        ((unsigned*)(Y + (size_t)m * 2048 + h * 128))[lane] = pk2(a0 * inv * __uint_as_float(zz << 16), a1 * inv * __uint_as_float(zz & 0xffff0000u));
    }
    for (int it = gw; it < M * NH; it += NGW) {
        const int h = it & 7, m = it >> 3, b = m >> 11, s = m & 2047;
        const size_t hb = (size_t)(b * 8 + h) * SEQ;
        const float lg2 = log2f(1.0f - exp2f(-5.0f - (float)h));
        const unsigned qq = ((const unsigned*)(QB + (hb + s) * 128))[lane];
        LDS_WAIT();
        qs[2 * lane] = __uint_as_float(qq << 16); qs[2 * lane + 1] = __uint_as_float(qq & 0xffff0000u);
        LDS_WAIT();
        float a0 = 0.f, a1 = 0.f;
        for (int c0 = 0; c0 <= s; c0 += 64) {
            const int key = c0 + lane; float w = 0.f;
            if (key <= s) w = dot_q_krow(qs, KB + (hb + key) * 128) * __builtin_amdgcn_exp2f((float)(s - key) * lg2);
            LDS_WAIT();
            ps[lane] = w;
            LDS_WAIT();
            const int kmax = (s - c0) < 63 ? (s - c0) : 63;
            const unsigned* vp = (const unsigned*)(VB + (hb + c0) * 128) + lane;
#pragma unroll 4
            for (int e = 0; e <= kmax; ++e) { const float pw = ps[e]; const unsigned vv = vp[(size_t)e * 64];
                a0 += pw * __uint_as_float(vv << 16); a1 += pw * __uint_as_float(vv & 0xffff0000u); }
        }
        const float ss = wave_sum(a0 * a0 + a1 * a1);
        const float r = 1.0f / sqrtf(ss * (1.0f / 128.0f) + EPS);
        const unsigned zz = ((const unsigned*)(ZB + (hb + s) * 128))[lane];
        ((unsigned*)(Y + (size_t)m * 2048 + 1024 + h * 128))[lane] = pk2(a0 * r * __uint_as_float(zz << 16), a1 * r * __uint_as_float(zz & 0xffff0000u));
    }
}

__global__ void __launch_bounds__(512, 2) mega_fwd(Args a) {
    extern __shared__ __attribute__((aligned(16))) unsigned char lds_raw[];
    LAS unsigned char* lds = (LAS unsigned char*)lds_raw;
    cg::grid_group grid = cg::this_grid();
    const int tid = threadIdx.x, lane = tid & 63, wave = __builtin_amdgcn_readfirstlane(tid >> 6);
    const int G = gridDim.x;
    unsigned char* ws = a.ws;

    p0_prologue(a, lds, wave, lane, G);
    grid.sync();

    {
        pg8::Gemm g{(const bf16_t*)(ws + WS_HBF), (const bf16_t*)(ws + WS_W1T), M, DIN, DM};
        pg8::StaticOrder S; S.init(M, DIN, G, (int)blockIdx.x);
        EpiProj E{(bf16_t*)(ws + WS_PROJ), (bf16_t*)(ws + WS_G), (float*)(ws + WS_KMEAN), (const float*)(ws + WS_CS)};
        pg8::gemm_phase<EpiProj, pg8::StaticOrder, true, true>(lds, g, S, E);
    }
    grid.sync();

    p2_simple(a, lds, tid, wave, lane, G);
    grid.sync();

    {
        pg8::Gemm g{(const bf16_t*)(ws + WS_Y), (const bf16_t*)(ws + WS_WABT), M, DM, DM};
        pg8::StaticOrder S; S.init(M, DM, G, (int)blockIdx.x);
        EpiMerge E{(const bf16_t*)(ws + WS_G), (bf16_t*)(ws + WS_MRG)};
        pg8::gemm_phase<EpiMerge, pg8::StaticOrder, true, true>(lds, g, S, E);
    }
    grid.sync();

    {
        pg8::Gemm g{(const bf16_t*)(ws + WS_MRG), (const bf16_t*)(ws + WS_WOT), M, DM, DM};
        pg8::StaticOrder S; S.init(M, DM, G, (int)blockIdx.x);
        EpiX1 E{a.in[0], a.out, (bf16_t*)(ws + WS_HBF), (float*)(ws + WS_SSQ1)};
        pg8::gemm_phase<EpiX1, pg8::StaticOrder, true, true>(lds, g, S, E);
    }
    grid.sync();

    {
        pg8::StaticOrder S; S.init(M, DM, G, (int)blockIdx.x);
        {
            pg8::Gemm g{(const bf16_t*)(ws + WS_PBF), (const bf16_t*)(ws + WS_WPPT), M, DM, DPLE};
            EpiPP E{(float*)(ws + WS_PPT)};
            pg8::gemm_phase<EpiPP, pg8::StaticOrder, true, true>(lds, g, S, E);
        }
        LAS float* rstd = (LAS float*)(lds + LDS_MISC + 1024);
        {
            Unit u; S.next(0, u);
            const int r = tid >> 1, hf = tid & 1;
            const f32x4* sp = (const f32x4*)((const float*)(ws + WS_SSQ1) + (size_t)(u.pm * 256 + r) * 32 + hf * 16);
            const f32x4 s0 = sp[0], s1 = sp[1], s2 = sp[2], s3 = sp[3];
            float ss = ((s0[0] + s0[1]) + (s0[2] + s0[3])) + ((s1[0] + s1[1]) + (s1[2] + s1[3])) + ((s2[0] + s2[1]) + (s2[2] + s2[3])) + ((s3[0] + s3[1]) + (s3[2] + s3[3]));
            ss += __shfl_xor(ss, 1);
            if (hf == 0) rstd[r] = 1.0f / sqrtf(ss * (1.0f / DM) + EPS);
        }
        __syncthreads();
        {
            pg8::Gemm g{(const bf16_t*)(ws + WS_HBF), (const bf16_t*)(ws + WS_WPGT), M, DM, DM};
            EpiX2 E{(const float*)(ws + WS_PPT), a.out, (float*)(ws + WS_SSQ2), rstd};
            pg8::gemm_phase<EpiX2, pg8::StaticOrder, true, true>(lds, g, S, E);
        }
    }
    grid.sync();

    {
        const int gw = blockIdx.x * 8 + wave, NGW = G * 8;
        const float* ssq = (const float*)(ws + WS_SSQ2); const float* gf = a.in[11];
        for (int m = gw; m < M; m += NGW) {
            float ss = (lane < 32) ? ssq[(size_t)m * 32 + lane] : 0.f;
            ss = wave_sum(ss);
            const float rstd = 1.0f / sqrtf(ss * (1.0f / DM) + EPS);
            f32x4* xr = (f32x4*)(a.out + (size_t)m * DM) + lane;
#pragma unroll
            for (int j = 0; j < 8; ++j) { const f32x4 gv = ((const f32x4*)gf)[lane + 64 * j]; f32x4 v = xr[64 * j]; v = v * rstd * gv; xr[64 * j] = v; }
        }
    }
}

extern "C" void kernel_launch(void* const* d_in, const int* in_sizes, int n_in, void* d_out, int out_size, void* d_ws, size_t ws_size, hipStream_t stream) {
    static int grid = 0;
    if (grid == 0) {
        if (n_in != 12 || out_size != M * DM || ws_size < WS_END) { fprintf(stderr, "kernel_launch: unexpected problem shape (n_in %d out %d ws %zu)\n", n_in, out_size, ws_size); grid = -1; return; }
        int dev = 0, cus = 0, per_cu = 0;
        (void)hipGetDevice(&dev);
        (void)hipDeviceGetAttribute(&cus, hipDeviceAttributeMultiprocessorCount, dev);
        if (hipFuncSetAttribute((const void*)mega_fwd, hipFuncAttributeMaxDynamicSharedMemorySize, LDS_BYTES) != hipSuccess) { fprintf(stderr, "kernel_launch: hipFuncSetAttribute failed\n"); grid = -1; return; }
        if (hipOccupancyMaxActiveBlocksPerMultiprocessor(&per_cu, (const void*)mega_fwd, 512, LDS_BYTES) != hipSuccess || per_cu < 1) { fprintf(stderr, "kernel_launch: occupancy query failed (%d)\n", per_cu); (void)hipGetLastError(); per_cu = 1; }
        grid = cus * 1;
        if (grid != 256) { fprintf(stderr, "kernel_launch: %d CUs; this kernel needs exactly 256 workgroups (one 256x256 unit each in P3..P5)\n", grid); grid = -1; return; }
    }
    if (grid < 0) return;
    Args a{};
    for (int i = 0; i < 12; ++i) a.in[i] = (const float*)d_in[i];
    a.out = (float*)d_out; a.ws = (unsigned char*)d_ws;
    void* args[] = {&a};
    hipError_t e = hipLaunchCooperativeKernel((const void*)mega_fwd, dim3(grid), dim3(512), args, LDS_BYTES, stream);
    if (e != hipSuccess) fprintf(stderr, "kernel_launch: cooperative launch failed: %s (grid %d)\n", hipGetErrorString(e), grid);
}
```

```cpp
#include <hip/hip_runtime.h>
#include <hip/hip_cooperative_groups.h>
#include <cstdio>
#include <cstdint>
namespace cg = cooperative_groups;

#define LAS __attribute__((address_space(3)))
typedef unsigned short bf16_t;
typedef short bf16x8 __attribute__((ext_vector_type(8)));
typedef float f32x4 __attribute__((ext_vector_type(4)));
typedef float f32x2 __attribute__((ext_vector_type(2)));
typedef unsigned u32x4 __attribute__((ext_vector_type(4)));
typedef unsigned u32x2 __attribute__((ext_vector_type(2)));

constexpr int NB = 4, SEQ = 2048, DM = 2048, M = NB * SEQ, DIN = 12288, NH = 8, DH = 128, LBLK = 256, DPLE = 256;
constexpr float EPS = 1e-6f, LOG2E = 1.4426950408889634f;
constexpr float QSCALE_A = 0.08838834764831845f * LOG2E;
constexpr float KSCALE_B = 0.08838834764831845f;

constexpr size_t MiB = 1u << 20;
constexpr size_t WS_KMEAN = 64 * 1024;
constexpr size_t WS_CS = 1 * MiB;
constexpr size_t WS_W1T = 2 * MiB;
constexpr size_t WS_WABT = 50 * MiB;
constexpr size_t WS_WOT = 58 * MiB;
constexpr size_t WS_WPGT = 66 * MiB;
constexpr size_t WS_WPPT = 74 * MiB;
constexpr size_t WS_PBF = 75 * MiB;
constexpr size_t WS_SSQ1 = 79 * MiB;
constexpr size_t WS_SSQ2 = 80 * MiB;
constexpr size_t WS_HBF = 82 * MiB;
constexpr size_t WS_Y = 114 * MiB;
constexpr size_t WS_MRG = 146 * MiB;
constexpr size_t WS_PROJ = 178 * MiB;
constexpr size_t WS_G = 306 * MiB;
constexpr size_t WS_PPT = 178 * MiB;
constexpr size_t WS_END = 370 * MiB;
constexpr size_t HM = (size_t)M * 1024;

constexpr int LDS_BYTES = 147456;
constexpr int LDS_MISC = 131072;

__device__ __forceinline__ float bf2f(unsigned short v) { return __uint_as_float((unsigned)v << 16); }
__device__ __forceinline__ unsigned f2bf(float f) { unsigned u = __float_as_uint(f); return (u + 0x7fffu + ((u >> 16) & 1u)) >> 16; }
__device__ __forceinline__ unsigned pk2(float lo, float hi) { return f2bf(lo) | (f2bf(hi) << 16); }
template <int MASK> __device__ __forceinline__ float shx(float v) {
    return __int_as_float(__builtin_amdgcn_ds_swizzle(__float_as_int(v), (MASK << 10) | 0x1f));
}
__device__ __forceinline__ float half_sum(float v) {
    auto rr = __builtin_amdgcn_permlane32_swap(__float_as_uint(v), __float_as_uint(v), false, false);
    return __uint_as_float(rr[0]) + __uint_as_float(rr[1]);
}
__device__ __forceinline__ float wave_sum(float v) {
    v += shx<1>(v); v += shx<2>(v); v += shx<4>(v); v += shx<8>(v); v += shx<16>(v);
    return half_sum(v);
}
__device__ __forceinline__ float fast_sigmoid(float v) { return __builtin_amdgcn_rcpf(1.0f + __builtin_amdgcn_exp2f(-v * LOG2E)); }
#define LDS_WAIT() asm volatile("s_waitcnt lgkmcnt(0)" ::: "memory")
#define OPAQUE_LANE_COORDS() int t__ = threadIdx.x; asm volatile("" : "+v"(t__)); const int wr = t__ >> 8, wc = (t__ >> 6) & 3, fr = t__ & 15, fq = (t__ >> 4) & 3

namespace pg8 {
constexpr int BM = 256, BK = 64, HALF = 128, HTB = HALF * BK * 2, STAGE_BYTES = 8 * HTB, NXCD = 8, WGM = 8;
__host__ __device__ __forceinline__ int lds_byte(int r, int c) { const int st = (r >> 4) * 2 + (c >> 5), rr = r & 15, cc = c & 31, ob = rr * 64 + cc * 2; return st * 1024 + (ob ^ (((ob >> 9) & 1) << 5)); }
__host__ __device__ __forceinline__ void stage_rc(int b, int& R, int& C) { const int st = b / 1024, sb = b % 1024, swz = sb ^ (((sb >> 9) & 1) << 5); R = (st >> 1) * 16 + swz / 64; C = (st & 1) * 32 + (swz % 64) / 2; }
__host__ __device__ __forceinline__ int perm32(int rho) { const int n = rho >> 4, i = rho & 15; return 8 * (i >> 2) + 4 * n + (i & 3); }
struct Unit { int pm, pn; };
struct Gemm { const bf16_t* A; const bf16_t* Bt; int M, N, K; };
struct StaticOrder {
    int nM, nN, nwg, G, c;
    __host__ __device__ void init(int M_, int N_, int G_, int c_) { nM = M_ / BM; nN = N_ / BM; nwg = nM * nN; G = G_; c = c_; }
    __host__ __device__ bool next(int i, Unit& u) const {
        const long L = (long)i * G + c; if (L >= nwg) return false;
        int wgid = (int)L; { const int q = nwg / NXCD, r = nwg % NXCD, xcd = wgid % NXCD, off = wgid / NXCD; wgid = (xcd < r ? xcd * (q + 1) : r * (q + 1) + (xcd - r) * q) + off; }
        const int nig = WGM * nN, gid = wgid / nig, fm = gid * WGM, gsz = (nM - fm) < WGM ? (nM - fm) : WGM;
        u.pm = fm + ((wgid % nig) % gsz); u.pn = (wgid % nig) / gsz; return true;
    }
};
__device__ __forceinline__ unsigned cvt_pk_bf16(float lo, float hi) { unsigned r; asm volatile("v_cvt_pk_bf16_f32 %0, %1, %2" : "=v"(r) : "v"(lo), "v"(hi)); return r; }

template <class Epi, class Sched, bool ALIGN_EPI, bool SP2>
__device__ __forceinline__ void gemm_phase(LAS unsigned char* lds, const Gemm g, const Sched& S, const Epi& E) {
    int tid = threadIdx.x; asm volatile("" : "+v"(tid));
    const int wid = __builtin_amdgcn_readfirstlane(tid >> 6), lane = tid & 63, wr = wid >> 2, wc = wid & 3, fr = lane & 15, fq = lane >> 4;
    const int K = g.K, nt = K / BK;
    unsigned voffA[2], voffB[2];
#pragma unroll
    for (int i = 0; i < 2; ++i) { int R, C; stage_rc(tid * 16 + i * 8192, R, C); const int Rb = Epi::PERM ? ((R & ~31) + perm32(R & 31)) : R;
        voffA[i] = (unsigned)(R * K + C) * 2u; voffB[i] = (unsigned)(Rb * K + C) * 2u; }
    const size_t kstep = (size_t)(BK * 2);
    const size_t hstep = (size_t)HALF * K * 2;
    const size_t tstep = 2 * hstep;
    const unsigned ldsw = (unsigned)wid * 1024u;
    const int aoff = lds_byte(wr * 64 + fr, fq * 8), boff = lds_byte(wc * 32 + fr, fq * 8);
#define PG8_SA(b, h) (((b) * 2 + (h)) * HTB)
#define PG8_SB(b, h) ((4 + (b) * 2 + (h)) * HTB)
#define PG8_STAGE(bufoff, gbase, voff) do { _Pragma("unroll") for (int _i = 0; _i < 2; ++_i) \
        __builtin_amdgcn_global_load_lds((const unsigned*)((const char*)(gbase) + (voff)[_i]), (LAS unsigned*)(lds + (bufoff) + ldsw + _i * 8192), 16, 0, 0); } while (0)
#define PG8_LDA(dst, b, h) do { _Pragma("unroll") for (int m = 0; m < 4; ++m) _Pragma("unroll") for (int k = 0; k < 2; ++k) dst[m][k] = *(const LAS bf16x8*)(lds + PG8_SA(b, h) + aoff + m * 2048 + k * 1024); } while (0)
#define PG8_LDB(dst, b, h) do { _Pragma("unroll") for (int n = 0; n < 2; ++n) _Pragma("unroll") for (int k = 0; k < 2; ++k) dst[n][k] = *(const LAS bf16x8*)(lds + PG8_SB(b, h) + boff + n * 2048 + k * 1024); } while (0)
#define PG8_MMA(ai, bj, At, Bt) do { __builtin_amdgcn_s_setprio(1); _Pragma("unroll") for (int m = 0; m < 4; ++m) _Pragma("unroll") for (int n = 0; n < 2; ++n) _Pragma("unroll") for (int k = 0; k < 2; ++k) \
        acc[ai][bj][m][n] = __builtin_amdgcn_mfma_f32_16x16x32_bf16(Bt[n][k], At[m][k], acc[ai][bj][m][n], 0, 0, 0); __builtin_amdgcn_s_setprio(0); } while (0)
#define PG8_WAIT_V(n) asm volatile("s_waitcnt vmcnt(" #n ")" ::: "memory")
#define PG8_WAIT_L(n) asm volatile("s_waitcnt lgkmcnt(" #n ")" ::: "memory")
#define PG8_BAR __builtin_amdgcn_s_barrier()
#define PG8_SCHED __builtin_amdgcn_sched_barrier(0)
    Unit cur, nxt; int ui = 0;
    if (!S.next(0, cur)) return;
    f32x4 acc[2][2][4][2];
#pragma unroll
    for (int a = 0; a < 2; ++a)
#pragma unroll
        for (int b = 0; b < 2; ++b)
#pragma unroll
            for (int m = 0; m < 4; ++m)
#pragma unroll
                for (int n = 0; n < 2; ++n) acc[a][b][m][n] = (f32x4){0.f, 0.f, 0.f, 0.f};
    bf16x8 At[4][2], B0[2][2], B1[2][2];
    const char* cA = (const char*)g.A + (size_t)cur.pm * tstep; const char* cB = (const char*)g.Bt + (size_t)cur.pn * tstep;
    if constexpr (SP2) {
        PG8_STAGE(PG8_SB(0, 0), cB, voffB); PG8_STAGE(PG8_SB(0, 1), cB + hstep, voffB); PG8_STAGE(PG8_SA(0, 0), cA, voffA); PG8_STAGE(PG8_SA(0, 1), cA + hstep, voffA);
        if (wr == 1) PG8_BAR;
        PG8_WAIT_V(2); PG8_BAR;
        PG8_STAGE(PG8_SB(1, 0), cB + kstep, voffB); PG8_STAGE(PG8_SA(1, 0), cA + kstep, voffA); PG8_STAGE(PG8_SB(1, 1), cB + hstep + kstep, voffB);
        PG8_WAIT_V(6); PG8_BAR;
    } else {
        PG8_STAGE(PG8_SB(0, 0), cB, voffB); PG8_STAGE(PG8_SA(0, 0), cA, voffA); PG8_STAGE(PG8_SB(0, 1), cB + hstep, voffB); PG8_STAGE(PG8_SA(0, 1), cA + hstep, voffA);
        if (wr == 1) PG8_BAR;
        PG8_WAIT_V(4); PG8_BAR;
        PG8_STAGE(PG8_SB(1, 0), cB + kstep, voffB); PG8_STAGE(PG8_SA(1, 0), cA + kstep, voffA); PG8_STAGE(PG8_SB(1, 1), cB + hstep + kstep, voffB);
        PG8_WAIT_V(6); PG8_BAR;
    }
    for (;;) {
        const bool has_next = S.next(ui + 1, nxt);
        const char* nA = has_next ? (const char*)g.A + (size_t)nxt.pm * tstep : cA; const char* nB = has_next ? (const char*)g.Bt + (size_t)nxt.pn * tstep : cB;
        for (int t = 0; t < nt; t += 2) {
            const bool last = (t == nt - 2);
            const char* a1 = cA + (size_t)(t + 1) * kstep;
            const char* a2 = last ? nA : cA + (size_t)(t + 2) * kstep; const char* b2 = last ? nB : cB + (size_t)(t + 2) * kstep;
            const char* a3 = a2 + kstep; const char* b3 = b2 + kstep;
            if constexpr (Epi::MID) { if (t == (nt >> 1)) E.mid(acc, cur, wr, wc, fr, fq); }
            if constexpr (SP2) {
            PG8_LDB(B0, 0, 0); PG8_LDB(B1, 0, 1); PG8_SCHED; PG8_LDA(At, 0, 0); PG8_STAGE(PG8_SA(1, 1), a1 + hstep, voffA);
            PG8_WAIT_V(8); PG8_WAIT_L(0); PG8_BAR; PG8_MMA(0, 0, At, B0); PG8_MMA(0, 1, At, B1); PG8_BAR; PG8_SCHED;
            PG8_LDA(At, 0, 1); PG8_STAGE(PG8_SB(0, 0), b2, voffB); PG8_STAGE(PG8_SB(0, 1), b2 + hstep, voffB); PG8_STAGE(PG8_SA(0, 0), a2, voffA);
            PG8_WAIT_V(8); PG8_WAIT_L(0); PG8_BAR; PG8_MMA(1, 0, At, B0); PG8_MMA(1, 1, At, B1); PG8_BAR; PG8_SCHED;
            PG8_LDB(B0, 1, 0); PG8_LDB(B1, 1, 1); PG8_SCHED; PG8_LDA(At, 1, 0); PG8_STAGE(PG8_SA(0, 1), a2 + hstep, voffA);
            PG8_WAIT_V(8); PG8_WAIT_L(0); PG8_BAR; PG8_MMA(0, 0, At, B0); PG8_MMA(0, 1, At, B1); PG8_BAR; PG8_SCHED;
            PG8_LDA(At, 1, 1); PG8_STAGE(PG8_SB(1, 0), b3, voffB); PG8_STAGE(PG8_SB(1, 1), b3 + hstep, voffB); PG8_STAGE(PG8_SA(1, 0), a3, voffA);
            PG8_WAIT_V(8); PG8_WAIT_L(0); PG8_BAR; PG8_MMA(1, 0, At, B0); PG8_MMA(1, 1, At, B1); PG8_BAR; PG8_SCHED;
            } else {
            PG8_LDB(B0, 0, 0); PG8_SCHED; PG8_LDA(At, 0, 0); PG8_STAGE(PG8_SA(1, 1), a1 + hstep, voffA);
            PG8_WAIT_L(8); PG8_BAR; PG8_WAIT_L(0); PG8_MMA(0, 0, At, B0); PG8_BAR; PG8_SCHED;
            PG8_LDB(B1, 0, 1); PG8_STAGE(PG8_SB(0, 0), b2, voffB);
            PG8_BAR; PG8_WAIT_L(0); PG8_MMA(0, 1, At, B1); PG8_BAR;
            PG8_LDA(At, 0, 1); PG8_STAGE(PG8_SA(0, 0), a2, voffA);
            PG8_BAR; PG8_WAIT_L(0); PG8_MMA(1, 0, At, B0); PG8_BAR; PG8_SCHED;
            PG8_STAGE(PG8_SB(0, 1), b2 + hstep, voffB);
            PG8_WAIT_V(6); PG8_BAR; PG8_MMA(1, 1, At, B1); PG8_BAR;
            PG8_LDB(B0, 1, 0); PG8_SCHED; PG8_LDA(At, 1, 0); PG8_STAGE(PG8_SA(0, 1), a2 + hstep, voffA);
            PG8_WAIT_L(8); PG8_BAR; PG8_WAIT_L(0); PG8_MMA(0, 0, At, B0); PG8_BAR; PG8_SCHED;
            PG8_LDB(B1, 1, 1); PG8_STAGE(PG8_SB(1, 0), b3, voffB);
            PG8_BAR; PG8_WAIT_L(0); PG8_MMA(0, 1, At, B1); PG8_BAR;
            PG8_LDA(At, 1, 1); PG8_STAGE(PG8_SA(1, 0), a3, voffA);
            PG8_BAR; PG8_WAIT_L(0); PG8_MMA(1, 0, At, B0); PG8_BAR; PG8_SCHED;
            PG8_STAGE(PG8_SB(1, 1), b3 + hstep, voffB);
            PG8_WAIT_V(6); PG8_BAR; PG8_MMA(1, 1, At, B1); PG8_BAR;
            }
        }
        if constexpr (ALIGN_EPI) { if (wr == 0) PG8_BAR; }
        E(acc, cur, wr, wc, fr, fq);
        if (!has_next) break;
#pragma unroll
        for (int a = 0; a < 2; ++a)
#pragma unroll
            for (int b = 0; b < 2; ++b)
#pragma unroll
                for (int m = 0; m < 4; ++m)
#pragma unroll
                    for (int n = 0; n < 2; ++n) acc[a][b][m][n] = (f32x4){0.f, 0.f, 0.f, 0.f};
        cur = nxt; cA = nA; cB = nB; ++ui;
        if constexpr (ALIGN_EPI) { if (wr == 1) PG8_BAR; }
    }
    PG8_WAIT_V(0);
    if constexpr (!ALIGN_EPI) { if (wr == 0) PG8_BAR; }
    PG8_BAR;
#undef PG8_SA
#undef PG8_SB
#undef PG8_STAGE
#undef PG8_LDA
#undef PG8_LDB
#undef PG8_MMA
#undef PG8_WAIT_V
#undef PG8_WAIT_L
#undef PG8_BAR
#undef PG8_SCHED
}
}

using pg8::Unit;
typedef f32x4 Acc[2][2][4][2];

struct EpiProj {
    static constexpr bool PERM = true, MID = false;
    bf16_t* proj; bf16_t* G; float* kmean; const float* cs;
    __device__ __forceinline__ void operator()(const Acc& acc, const Unit& u, int, int, int, int) const {
        OPAQUE_LANE_COORDS();
        const int seg = u.pn >> 2;
        if (seg >= 8) {
            const int row0 = u.pm * 256 + wr * 64 + fr, col0 = (u.pn - 32) * 256 + wc * 32 + 8 * fq;
#pragma unroll
            for (int ai = 0; ai < 2; ++ai)
#pragma unroll
                for (int m = 0; m < 4; ++m) { bf16_t* rowp = G + (size_t)(row0 + ai * 128 + m * 16) * 4096 + col0;
#pragma unroll
                    for (int bj = 0; bj < 2; ++bj) { const f32x4 v0 = acc[ai][bj][m][0], v1 = acc[ai][bj][m][1];
                        u32x4 w; w.x = pg8::cvt_pk_bf16(v0[0], v0[1]); w.y = pg8::cvt_pk_bf16(v0[2], v0[3]); w.z = pg8::cvt_pk_bf16(v1[0], v1[1]); w.w = pg8::cvt_pk_bf16(v1[2], v1[3]);
                        *(u32x4*)(rowp + bj * 128) = w; } }
            return;
        }
        bf16_t* base = proj + (size_t)seg * HM;
        const int b = u.pm >> 3, s0 = (u.pm & 7) * 256 + wr * 64 + fr, hq = (u.pn & 3) * 2, d0 = wc * 32 + 8 * fq;
        const bool rot = (seg == 4) || (seg == 5);
        float cs_[2][8];
#pragma unroll
        for (int bj = 0; bj < 2; ++bj)
#pragma unroll
            for (int i = 0; i < 8; ++i) cs_[bj][i] = 0.f;
#pragma unroll
        for (int ai = 0; ai < 2; ++ai)
#pragma unroll
            for (int m = 0; m < 4; ++m) {
                const int s = s0 + ai * 128 + m * 16;
                f32x4 c4 = (f32x4){1.f, 1.f, 1.f, 1.f}, s4 = (f32x4){0.f, 0.f, 0.f, 0.f};
                if (rot) { c4 = *(const f32x4*)(cs + (size_t)s * 64 + (d0 >> 1)); s4 = *(const f32x4*)(cs + (size_t)SEQ * 64 + (size_t)s * 64 + (d0 >> 1)); }
#pragma unroll
                for (int bj = 0; bj < 2; ++bj) {
                    f32x4 v0 = acc[ai][bj][m][0], v1 = acc[ai][bj][m][1];
                    if (seg == 0) { v0 = v0 * QSCALE_A; v1 = v1 * QSCALE_A; }
                    else if (seg == 1) {
#pragma unroll
                        for (int i = 0; i < 4; ++i) { cs_[bj][i] += v0[i]; cs_[bj][4 + i] += v1[i]; } }
                    else if (seg == 3 || seg == 7) {
#pragma unroll
                        for (int i = 0; i < 4; ++i) { v0[i] = v0[i] * fast_sigmoid(v0[i]); v1[i] = v1[i] * fast_sigmoid(v1[i]); } }
                    else if (rot) {
                        const float lg2 = log2f(1.0f - exp2f(-5.0f - (float)(hq + bj)));
                        const float sc = (seg == 5) ? KSCALE_B * __builtin_amdgcn_exp2f(-(float)s * lg2) : __builtin_amdgcn_exp2f((float)s * lg2);
                        f32x4 r0, r1;
                        r0[0] = (v0[0] * c4[0] - v0[1] * s4[0]) * sc; r0[1] = (v0[1] * c4[0] + v0[0] * s4[0]) * sc;
                        r0[2] = (v0[2] * c4[1] - v0[3] * s4[1]) * sc; r0[3] = (v0[3] * c4[1] + v0[2] * s4[1]) * sc;
                        r1[0] = (v1[0] * c4[2] - v1[1] * s4[2]) * sc; r1[1] = (v1[1] * c4[2] + v1[0] * s4[2]) * sc;
                        r1[2] = (v1[2] * c4[3] - v1[3] * s4[3]) * sc; r1[3] = (v1[3] * c4[3] + v1[2] * s4[3]) * sc;
                        v0 = r0; v1 = r1; }
                    u32x4 w; w.x = pg8::cvt_pk_bf16(v0[0], v0[1]); w.y = pg8::cvt_pk_bf16(v0[2], v0[3]); w.z = pg8::cvt_pk_bf16(v1[0], v1[1]); w.w = pg8::cvt_pk_bf16(v1[2], v1[3]);
                    *(u32x4*)(base + ((size_t)((b * 8 + hq + bj) * SEQ + s)) * 128 + d0) = w;
                }
            }
        if (seg == 1) {
#pragma unroll
            for (int bj = 0; bj < 2; ++bj)
#pragma unroll
                for (int i = 0; i < 8; ++i) { float v = cs_[bj][i]; v += shx<1>(v); v += shx<2>(v); v += shx<4>(v); v += shx<8>(v);
                    if (fr == 0) __hip_atomic_fetch_add(kmean + (size_t)u.pm * 1024 + (hq + bj) * 128 + d0 + i, v, __ATOMIC_RELAXED, __HIP_MEMORY_SCOPE_AGENT); }
        }
    }
};

struct EpiMerge {
    static constexpr bool PERM = true, MID = true;
    const bf16_t* G; bf16_t* out;
    __device__ __forceinline__ void mid(Acc& acc, const Unit& u, int, int, int, int) const {
        OPAQUE_LANE_COORDS();
        const int row0 = u.pm * 256 + wr * 64 + fr, col0 = u.pn * 256 + wc * 32 + 8 * fq;
#pragma unroll
        for (int ai = 0; ai < 2; ++ai)
#pragma unroll
            for (int m = 0; m < 4; ++m) { const bf16_t* gp = G + (size_t)(row0 + ai * 128 + m * 16) * 4096 + col0;
#pragma unroll
                for (int bj = 0; bj < 2; ++bj) { const u32x4 ga = *(const u32x4*)(gp + bj * 128), gb = *(const u32x4*)(gp + 2048 + bj * 128);
#pragma unroll
                    for (int i = 0; i < 4; ++i) {
                        const float a0 = __uint_as_float(ga[i] << 16), a1 = __uint_as_float(ga[i] & 0xffff0000u), b0 = __uint_as_float(gb[i] << 16), b1 = __uint_as_float(gb[i] & 0xffff0000u);
                        const float r0 = (1.0f + __builtin_amdgcn_exp2f(-b0 * LOG2E)) * __builtin_amdgcn_rcpf(1.0f + __builtin_amdgcn_exp2f(-a0 * LOG2E));
                        const float r1 = (1.0f + __builtin_amdgcn_exp2f(-b1 * LOG2E)) * __builtin_amdgcn_rcpf(1.0f + __builtin_amdgcn_exp2f(-a1 * LOG2E));
                        acc[ai][bj][m][i >> 1][(i & 1) * 2] *= r0; acc[ai][bj][m][i >> 1][(i & 1) * 2 + 1] *= r1; } } }
    }
    __device__ __forceinline__ void operator()(const Acc& acc, const Unit& u, int, int, int, int) const {
        OPAQUE_LANE_COORDS();
        const int row0 = u.pm * 256 + wr * 64 + fr, col0 = u.pn * 256 + wc * 32 + 8 * fq;
#pragma unroll
        for (int ai = 0; ai < 2; ++ai)
#pragma unroll
            for (int m = 0; m < 4; ++m) { const size_t row = (size_t)(row0 + ai * 128 + m * 16);
#pragma unroll
                for (int bj = 0; bj < 2; ++bj) { const u32x4 gb = *(const u32x4*)(G + row * 4096 + 2048 + col0 + bj * 128);
                    float o[8];
#pragma unroll
                    for (int i = 0; i < 4; ++i) { const float b0 = __uint_as_float(gb[i] << 16), b1 = __uint_as_float(gb[i] & 0xffff0000u);
                        o[2 * i] = acc[ai][bj][m][i >> 1][(i & 1) * 2] * fast_sigmoid(b0); o[2 * i + 1] = acc[ai][bj][m][i >> 1][(i & 1) * 2 + 1] * fast_sigmoid(b1); }
                    u32x4 w; w.x = pg8::cvt_pk_bf16(o[0], o[1]); w.y = pg8::cvt_pk_bf16(o[2], o[3]); w.z = pg8::cvt_pk_bf16(o[4], o[5]); w.w = pg8::cvt_pk_bf16(o[6], o[7]);
                    *(u32x4*)(out + row * 2048 + col0 + bj * 128) = w; } }
    }
};

struct EpiX1 {
    static constexpr bool PERM = false, MID = false;
    const float* x; float* x1; bf16_t* x1bf; float* ssq;
    __device__ __forceinline__ void operator()(const Acc& acc, const Unit& u, int, int, int, int) const {
        OPAQUE_LANE_COORDS();
        const int row0 = u.pm * 256 + wr * 64 + fr, col0 = u.pn * 256 + wc * 32 + 4 * fq;
#pragma unroll
        for (int ai = 0; ai < 2; ++ai)
#pragma unroll
            for (int m = 0; m < 4; ++m) { const size_t row = (size_t)(row0 + ai * 128 + m * 16); float ss = 0.f;
#pragma unroll
                for (int bj = 0; bj < 2; ++bj)
#pragma unroll
                    for (int n = 0; n < 2; ++n) { const size_t off = row * 2048 + col0 + bj * 128 + n * 16;
                        const f32x4 o = *(const f32x4*)(x + off) + acc[ai][bj][m][n];
                        *(f32x4*)(x1 + off) = o;
                        u32x2 w; w.x = pg8::cvt_pk_bf16(o[0], o[1]); w.y = pg8::cvt_pk_bf16(o[2], o[3]); *(u32x2*)(x1bf + off) = w;
                        ss += (o[0] * o[0] + o[1] * o[1]) + (o[2] * o[2] + o[3] * o[3]); }
                ss += shx<16>(ss); ss = half_sum(ss);
                if (fq == 0) ssq[row * 32 + u.pn * 4 + wc] = ss; }
    }
};
struct EpiPP {
    static constexpr bool PERM = false, MID = false;
    float* pp;
    __device__ __forceinline__ void operator()(const Acc& acc, const Unit& u, int, int, int, int) const {
        OPAQUE_LANE_COORDS();
        const int row0 = u.pm * 256 + wr * 64 + fr, col0 = u.pn * 256 + wc * 32 + 4 * fq;
#pragma unroll
        for (int ai = 0; ai < 2; ++ai)
#pragma unroll
            for (int m = 0; m < 4; ++m) { const size_t row = (size_t)(row0 + ai * 128 + m * 16);
#pragma unroll
                for (int bj = 0; bj < 2; ++bj)
#pragma unroll
                    for (int n = 0; n < 2; ++n) *(f32x4*)(pp + row * 2048 + col0 + bj * 128 + n * 16) = acc[ai][bj][m][n]; }
    }
};
struct EpiX2 {
    static constexpr bool PERM = false, MID = false;
    const float* pp; float* x1; float* ssq; const LAS float* rstd;
    __device__ __forceinline__ void operator()(const Acc& acc, const Unit& u, int, int, int, int) const {
        OPAQUE_LANE_COORDS();
        const int row0 = u.pm * 256 + wr * 64 + fr, col0 = u.pn * 256 + wc * 32 + 4 * fq;
#pragma unroll
        for (int ai = 0; ai < 2; ++ai)
#pragma unroll
            for (int m = 0; m < 4; ++m) { const size_t row = (size_t)(row0 + ai * 128 + m * 16); float ss = 0.f;
                const float rs = rstd[ai * 128 + wr * 64 + m * 16 + fr];
#pragma unroll
                for (int bj = 0; bj < 2; ++bj)
#pragma unroll
                    for (int n = 0; n < 2; ++n) { const size_t off = row * 2048 + col0 + bj * 128 + n * 16;
                        const f32x4 pv = *(const f32x4*)(pp + off), xv = *(const f32x4*)(x1 + off), a = acc[ai][bj][m][n];
                        f32x4 o;
#pragma unroll
                        for (int i = 0; i < 4; ++i) o[i] = xv[i] + fast_sigmoid(a[i] * rs) * pv[i];
                        *(f32x4*)(x1 + off) = o;
                        ss += (o[0] * o[0] + o[1] * o[1]) + (o[2] * o[2] + o[3] * o[3]); }
                ss += shx<16>(ss); ss = half_sum(ss);
                if (fq == 0) ssq[row * 32 + u.pn * 4 + wc] = ss; }
    }
};

struct Args { const float* in[12]; float* out; unsigned char* ws; };

__device__ __forceinline__ void p0_transpose_item(const float* W, int N, bf16_t* WT, int ldt, int coff, const float* sc, LAS float* scr, int item, int lane) {
    const int nblk = N / 32, kb = item / nblk, nb = item % nblk, k0 = 64 * kb, n0 = 32 * nb;
#pragma unroll 8
    for (int i = 0; i < 32; ++i) { const int kk = 2 * i + (lane >> 5); float v = W[(size_t)(k0 + kk) * N + n0 + (lane & 31)]; if (sc) v *= sc[k0 + kk]; scr[kk * 33 + (lane & 31)] = v; }
    LDS_WAIT();
    const int c = lane & 7;
#pragma unroll
    for (int j = 0; j < 4; ++j) { const int n = (lane >> 3) + 8 * j; const LAS float* s = scr + (8 * c) * 33 + n;
        u32x4 o; o.x = pk2(s[0 * 33], s[1 * 33]); o.y = pk2(s[2 * 33], s[3 * 33]); o.z = pk2(s[4 * 33], s[5 * 33]); o.w = pk2(s[6 * 33], s[7 * 33]);
        *(u32x4*)(WT + (size_t)(n0 + n) * ldt + coff + k0 + 8 * c) = o; }
    LDS_WAIT();
}
__device__ __forceinline__ void p0_prologue(const Args& a, LAS unsigned char* lds, int G) {
    int t__ = threadIdx.x; asm volatile("" : "+v"(t__));
    const int lane = t__ & 63, wave = __builtin_amdgcn_readfirstlane(t__ >> 6);
    unsigned char* ws = a.ws;
    LAS float* scr = (LAS float*)(lds + wave * 16384);
    const int gw = blockIdx.x * 8 + wave, NGW = G * 8;
    constexpr int I_IN = (DM / 64) * (DIN / 32), I_A = (1024 / 64) * (DM / 32), I_O = (DM / 64) * (DM / 32), I_PP = (DPLE / 64) * (DM / 32);
    constexpr int NITEMS = I_IN + 2 * I_A + 2 * I_O + I_PP;
    for (int it = gw; it < NITEMS; it += NGW) {
        int r = it;
        if (r < I_IN) { p0_transpose_item(a.in[3], DIN, (bf16_t*)(ws + WS_W1T), DM, 0, nullptr, scr, r, lane); continue; } r -= I_IN;
        if (r < I_A) { p0_transpose_item(a.in[4], DM, (bf16_t*)(ws + WS_WABT), DM, 0, nullptr, scr, r, lane); continue; } r -= I_A;
        if (r < I_A) { p0_transpose_item(a.in[5], DM, (bf16_t*)(ws + WS_WABT), DM, 1024, nullptr, scr, r, lane); continue; } r -= I_A;
        if (r < I_O) { p0_transpose_item(a.in[6], DM, (bf16_t*)(ws + WS_WOT), DM, 0, nullptr, scr, r, lane); continue; } r -= I_O;
        if (r < I_O) { p0_transpose_item(a.in[8], DM, (bf16_t*)(ws + WS_WPGT), DM, 0, a.in[7], scr, r, lane); continue; } r -= I_O;
        p0_transpose_item(a.in[9], DM, (bf16_t*)(ws + WS_WPPT), DPLE, 0, nullptr, scr, r, lane);
    }
    const float* x = a.in[0]; const float* p = a.in[1]; const float* g = a.in[2];
    bf16_t* hb = (bf16_t*)(ws + WS_HBF); bf16_t* pb = (bf16_t*)(ws + WS_PBF);
    for (int m = gw; m < M; m += NGW) {
        const f32x4* xr = (const f32x4*)(x + (size_t)m * DM) + lane;
        f32x4 v[8]; float ss = 0.f;
#pragma unroll
        for (int j = 0; j < 8; ++j) { v[j] = xr[64 * j]; ss += (v[j][0] * v[j][0] + v[j][1] * v[j][1]) + (v[j][2] * v[j][2] + v[j][3] * v[j][3]); }
        const float rstd = 1.0f / sqrtf(wave_sum(ss) * (1.0f / DM) + EPS);
        u32x2* o8 = (u32x2*)(hb + (size_t)m * DM) + lane;
#pragma unroll
        for (int j = 0; j < 8; ++j) { const f32x4 gv = ((const f32x4*)g)[lane + 64 * j]; u32x2 w; w.x = pk2(v[j][0] * rstd * gv[0], v[j][1] * rstd * gv[1]); w.y = pk2(v[j][2] * rstd * gv[2], v[j][3] * rstd * gv[3]); o8[64 * j] = w; }
        const f32x4 pv = ((const f32x4*)(p + (size_t)m * DPLE))[lane];
        u32x2 w; w.x = pk2(pv[0], pv[1]); w.y = pk2(pv[2], pv[3]); ((u32x2*)(pb + (size_t)m * DPLE))[lane] = w;
    }
    float* cs = (float*)(ws + WS_CS);
    for (int s = gw; s < SEQ; s += NGW) {
        const float theta = 1.0f / powf(10000.0f, (float)lane / 63.0f);
        const float ang = (float)s * theta;
        cs[(size_t)s * 64 + lane] = cosf(ang); cs[(size_t)SEQ * 64 + (size_t)s * 64 + lane] = sinf(ang);
    }
    float* km = (float*)(ws + WS_KMEAN);
    for (int i = gw * 64 + lane; i < 32 * 1024; i += NGW * 64) km[i] = 0.f;
}

namespace att {
typedef short s16x4 __attribute__((ext_vector_type(4)));
typedef float f32x16 __attribute__((ext_vector_type(16)));
constexpr int NW = 8, QBLK = 32, KVBLK = 64, D = 128;
constexpr int SHM_V = KVBLK * D * 2, SHM_K = KVBLK * D * 2;
constexpr int OFF_WS = 2 * SHM_V + 2 * SHM_K;
constexpr int OFF_STG = OFF_WS + NW * 64 * 4;
constexpr int OFF_TAB = OFF_STG + NW * 8192;
static_assert(OFF_TAB + 480 * 4 <= LDS_BYTES, "attention LDS map");
constexpr float THR = 8.f;

#define KSWZ(row, colB) ((row) * 256 + ((colB) ^ (((row) & 7) << 4)))
#define SBAR() __builtin_amdgcn_sched_barrier(0)
__device__ __forceinline__ int v_st(int k, int c) { const int kk = (k & ~0xC) | ((k & 4) << 1) | ((k & 8) >> 1); return ((kk >> 3) * 4 + (c >> 5)) * 512 + ((kk & 7) * 32 + (c & 31)) * 2; }
__device__ __forceinline__ int v_rd_base(int lane) { return ((lane & 3) << 3) | (((lane >> 2) & 3) << 6) | (((lane >> 4) & 1) << 5) | (((lane >> 5) & 1) << 8); }
constexpr int v_rd_off(int d0, int ks, int half) { return d0 * 512 + ks * 4096 + half * 2048; }
__device__ __forceinline__ int crow(int r, int hi) { return (r & 3) + 8 * (r >> 2) + 4 * hi; }
__device__ __forceinline__ unsigned cvtpk(float lo, float hi) { unsigned r; asm volatile("v_cvt_pk_bf16_f32 %0, %1, %2" : "=v"(r) : "v"(lo), "v"(hi)); return r; }
__device__ __forceinline__ bf16x8 ld8(const bf16_t* p) { return *reinterpret_cast<const bf16x8*>(p); }
__device__ __forceinline__ int t5_bucket(int n) {
    if (n < 16) return n;
    const float v = logf((float)n / 16.0f) / logf(8.0f) * 16.0f;
    const int l = 16 + (int)v;
    return l < 31 ? l : 31;
}
__device__ __forceinline__ void zero_tile(f32x16& p0, f32x16& p1, int dq) {
#pragma unroll
    for (int r = 0; r < 16; ++r) { const int c = (r & 3) + 8 * (r >> 2); if (dq - c < 0) p0[r] = 0.f; if (dq - c - 32 < 0) p1[r] = 0.f; }
}
__device__ __forceinline__ void bias_tile(f32x16& p0, f32x16& p1, const float* tp) {
#pragma unroll
    for (int r = 0; r < 16; ++r) { const int c = (r & 3) + 8 * (r >> 2); p0[r] += tp[c]; p1[r] += tp[c + 32]; }
}
template <int MODE> __device__ __forceinline__ void partialSM(f32x16& p0, f32x16& p1, float& m_reg, float& mn, float& alpha) {
    if (MODE == 1) { mn = 0.f; alpha = 1.f; return; }
    float pmax = p0[0];
#pragma unroll
    for (int r = 1; r < 16; ++r) pmax = fmaxf(pmax, p0[r]);
#pragma unroll
    for (int r = 0; r < 16; ++r) pmax = fmaxf(pmax, p1[r]);
    { auto rr = __builtin_amdgcn_permlane32_swap(__float_as_uint(pmax), __float_as_uint(pmax), false, false); pmax = fmaxf(__uint_as_float(rr[0]), __uint_as_float(rr[1])); }
    if (__builtin_expect(__all((pmax - m_reg) <= THR), 1)) { mn = m_reg; alpha = 1.f; }
    else { mn = fmaxf(m_reg, pmax); alpha = __builtin_amdgcn_exp2f(m_reg - mn); m_reg = mn; }
#pragma unroll
    for (int r = 0; r < 16; ++r) p0[r] = p0[r] - mn;
#pragma unroll
    for (int r = 0; r < 16; ++r) p1[r] = p1[r] - mn;
#pragma unroll
    for (int r = 0; r < 16; ++r) p0[r] = __builtin_amdgcn_exp2f(p0[r]);
}
template <int MODE> __device__ __forceinline__ void finishSM(f32x16& p0, f32x16& p1, float alpha, float& l_reg, bf16x8& pa0, bf16x8& pa1, bf16x8& pa2, bf16x8& pa3) {
    if (MODE == 0) {
#pragma unroll
        for (int r = 0; r < 16; ++r) p1[r] = __builtin_amdgcn_exp2f(p1[r]);
        float ps = 0;
#pragma unroll
        for (int r = 0; r < 16; ++r) ps += p0[r];
#pragma unroll
        for (int r = 0; r < 16; ++r) ps += p1[r];
        { auto rr = __builtin_amdgcn_permlane32_swap(__float_as_uint(ps), __float_as_uint(ps), false, false); ps = __uint_as_float(rr[0]) + __uint_as_float(rr[1]); }
        l_reg = l_reg * alpha + ps;
    }
#define PK4(P, B_, OUT) do { unsigned a0 = cvtpk(P[B_+0], P[B_+1]), a1 = cvtpk(P[B_+2], P[B_+3]);                          \
        unsigned b0 = cvtpk(P[B_+4], P[B_+5]), b1 = cvtpk(P[B_+6], P[B_+7]);                                             \
        auto r0 = __builtin_amdgcn_permlane32_swap(a0, b0, false, false); auto r1 = __builtin_amdgcn_permlane32_swap(a1, b1, false, false); \
        u32x4 w = {r0[0], r1[0], r0[1], r1[1]}; OUT = *reinterpret_cast<bf16x8*>(&w); } while (0)
    PK4(p0, 0, pa0); PK4(p0, 8, pa1); PK4(p1, 0, pa2); PK4(p1, 8, pa3);
#undef PK4
}
template <int KB>
__device__ __forceinline__ void qkt(f32x16& p0, f32x16& p1, const char* K_lds, int r32, int hi, const bf16x8* qr, float ci) {
#pragma unroll
    for (int r = 0; r < 16; ++r) { p0[r] = ci; p1[r] = ci; }
    const char* kb[4];
#pragma unroll
    for (int dd = 0; dd < 4; ++dd) kb[dd] = K_lds + KB * SHM_K + KSWZ(r32, (dd * 16 + hi * 8) * 2);
#pragma unroll
    for (int d0 = 0; d0 < 8; ++d0) { const char* a = kb[d0 & 3] + (d0 >> 2) * 128;
        bf16x8 b0 = *reinterpret_cast<const bf16x8*>(a);
        bf16x8 b1 = *reinterpret_cast<const bf16x8*>(a + 32 * 256);
        p0 = __builtin_amdgcn_mfma_f32_32x32x16_bf16(b0, qr[d0], p0, 0, 0, 0);
        p1 = __builtin_amdgcn_mfma_f32_32x32x16_bf16(b1, qr[d0], p1, 0, 0, 0); }
}
template <int VB>
__device__ __forceinline__ void pv_tile(f32x16* o, int vb0, bf16x8 pa0, bf16x8 pa1, bf16x8 pa2, bf16x8 pa3) {
#define TRRD(dst, off) asm volatile("ds_read_b64_tr_b16 %0, %1 offset:%2" : "=&v"(dst) : "v"(vb0), "i"(off) : "memory")
#define PV_D0(d0) do { s16x4 l0, l1, l2, l3, h0, h1, h2, h3; constexpr int b_ = VB * SHM_V + v_rd_off(d0, 0, 0); \
        TRRD(l0, b_); TRRD(h0, b_ + 2048); TRRD(l1, b_ + 4096); TRRD(h1, b_ + 6144); TRRD(l2, b_ + 8192); TRRD(h2, b_ + 10240); TRRD(l3, b_ + 12288); TRRD(h3, b_ + 14336); \
        asm volatile("s_waitcnt lgkmcnt(0)" ::: "memory"); SBAR(); \
        o[d0] = __builtin_amdgcn_mfma_f32_32x32x16_bf16(pa0, (bf16x8){l0[0], l0[1], l0[2], l0[3], h0[0], h0[1], h0[2], h0[3]}, o[d0], 0, 0, 0);   \
        o[d0] = __builtin_amdgcn_mfma_f32_32x32x16_bf16(pa1, (bf16x8){l1[0], l1[1], l1[2], l1[3], h1[0], h1[1], h1[2], h1[3]}, o[d0], 0, 0, 0);   \
        o[d0] = __builtin_amdgcn_mfma_f32_32x32x16_bf16(pa2, (bf16x8){l2[0], l2[1], l2[2], l2[3], h2[0], h2[1], h2[2], h2[3]}, o[d0], 0, 0, 0);   \
        o[d0] = __builtin_amdgcn_mfma_f32_32x32x16_bf16(pa3, (bf16x8){l3[0], l3[1], l3[2], l3[3], h3[0], h3[1], h3[2], h3[3]}, o[d0], 0, 0, 0); } while (0)
    PV_D0(0); PV_D0(1); PV_D0(2); PV_D0(3);
#undef PV_D0
#undef TRRD
}

struct BlockRef { const bf16_t* Q; const bf16_t* K; const bf16_t* V; const bf16_t* Z; bf16_t* Y; int n, h, b; };
struct Seam { bf16x8 qr[8]; bf16x8 st_v0, st_v1, st_k0, st_k1; };
#define ROW(p, k0, rr) ((p) + (size_t)((k0) + (rr)) * D + sc)
#define VMW() asm volatile("s_waitcnt vmcnt(0)" ::: "memory")
#define VMWN(n) asm volatile("s_waitcnt vmcnt(%0)" :: "i"(n) : "memory")
#define SLOAD_H(Kp, Vp, k0) do { S.st_v0 = ld8(ROW(Vp, k0, sr)); S.st_v1 = ld8(ROW(Vp, k0, 32 + sr)); S.st_k0 = ld8(ROW(Kp, k0, sr)); S.st_k1 = ld8(ROW(Kp, k0, 32 + sr)); } while (0)
#define SWRITE_HK(bf) do { *(bf16x8*)(K_lds + (bf) * SHM_K + kws) = S.st_k0; *(bf16x8*)(K_lds + (bf) * SHM_K + kws + 32 * 256) = S.st_k1; } while (0)
#define SWRITE_HV(bf) do { *(bf16x8*)(V_lds + (bf) * SHM_V + vst0) = S.st_v0; *(bf16x8*)(V_lds + (bf) * SHM_V + vst1) = S.st_v1; } while (0)
#define SWRITE_H(bf) do { SWRITE_HV(bf); SWRITE_HK(bf); } while (0)
__device__ __forceinline__ void attn_prime(const BlockRef& cur, char* lds, Seam& S) {
    const int tid = threadIdx.x, wid = __builtin_amdgcn_readfirstlane(tid >> 6), lane = tid & 63, r32 = lane & 31, hi = lane >> 5;
    const int sr = tid >> 4, sc = (tid & 15) * 8, kws = KSWZ(sr, sc * 2); char* K_lds = lds + 2 * SHM_V;
#pragma unroll
    for (int d0 = 0; d0 < 8; ++d0) S.qr[d0] = ld8(cur.Q + (size_t)(wid * QBLK + r32) * D + d0 * 16 + hi * 8);
    SLOAD_H(cur.K, cur.V, 0); VMW(); SWRITE_HK(0);
    __syncthreads();
}
template <int MODE>
__device__ __forceinline__ void attn_block(const BlockRef& cur, const BlockRef& nxt, char* lds, Seam& S, const float* kmsum, const float* rel_bias) {
    const int tid = threadIdx.x, wid = __builtin_amdgcn_readfirstlane(tid >> 6), lane = tid & 63, r32 = lane & 31, hi = lane >> 5;
    const int n = cur.n, NT = 4 * n + 4;
    const int qlo = n * 256 + wid * QBLK, qm = qlo + r32 - 4 * hi;
    char* V_lds = lds; char* K_lds = lds + 2 * SHM_V;
    float* ws = (float*)(lds + OFF_WS) + wid * 64; float* li_l = ws, * al_l = ws + 32;
    float m_reg = -1e30f, l_reg = 0; f32x16 o[4] = {};
    const int sr = tid >> 4, sc = (tid & 15) * 8, vst0 = v_st(sr, sc), vst1 = v_st(32 + sr, sc), kws = KSWZ(sr, sc * 2);
    const int vb0 = (int)(uintptr_t)V_lds + v_rd_base(lane);
    const bf16_t* Kh = cur.K; const bf16_t* Vh = cur.V;
    const float NEG = -__builtin_inff();
    unsigned selbits = 0u; float b31 = 0.f; const float* RT = (const float*)(lds + OFF_TAB);
    if (MODE == 0) {
        char* KM = lds + OFF_STG;
        { const int row = tid >> 6, c2 = (tid & 63) * 2;
          const float* kp = kmsum + (size_t)(cur.b * 8 + row) * 1024 + cur.h * 128 + c2;
          *(unsigned*)(KM + KSWZ(row, c2 * 2)) = pk2(kp[0] * (1.0f / 256.0f), kp[1] * (1.0f / 256.0f)); }
        if (tid < 480) { const int dist = 222 - tid; float v = NEG; if (dist >= 0) v = rel_bias[t5_bucket(dist < 128 ? dist : 128) * NH + cur.h] * LOG2E; ((float*)(lds + OFF_TAB))[tid] = v; }
        b31 = rel_bias[31 * NH + cur.h] * LOG2E;
        __syncthreads();
        f32x16 g = {};
#pragma unroll
        for (int d0 = 0; d0 < 8; ++d0) g = __builtin_amdgcn_mfma_f32_32x32x16_bf16(*reinterpret_cast<const bf16x8*>(KM + KSWZ(r32, d0 * 32 + hi * 16)), S.qr[d0], g, 0, 0, 0);
        float gt[8];
#pragma unroll
        for (int j = 0; j < 4; ++j) { auto rr = __builtin_amdgcn_permlane32_swap(__float_as_uint(g[j]), __float_as_uint(g[j]), false, false); gt[j] = __uint_as_float(rr[0]); gt[4 + j] = __uint_as_float(rr[1]); }
#pragma unroll
        for (int j = 0; j < 8; ++j) { int rank = 0;
#pragma unroll
            for (int k = 0; k < 8; ++k) if (k != j) rank += (k < n && (gt[k] > gt[j] || (gt[k] == gt[j] && k < j))) ? 1 : 0;
            if (j < n && rank < 3) selbits |= 1u << j; }
    }
#define RESC(a) do { if (MODE == 0) { if (__any((a) < 1.f)) { if (hi == 0) al_l[r32] = (a); asm volatile("s_waitcnt lgkmcnt(0)" ::: "memory");              \
                     for (int d_ = 0; d_ < 4; ++d_) for (int r = 0; r < 16; ++r) o[d_][r] *= al_l[crow(r, hi)]; } } } while (0)
#define KBASE(t) ((t) * KVBLK)
#define CINIT(var, t) float var = 0.f; if (MODE == 0) { const int kb_ = KBASE(t), j_ = (t) >> 2; var = (qlo - kb_ - 63 >= 128) ? b31 : 0.f; if (j_ < n && !((selbits >> j_) & 1u)) var = NEG; }
#define MASKT(P0_, P1_, t) do { const int kb_ = KBASE(t); \
        if (MODE == 0) { if (qlo - kb_ - 63 < 128) bias_tile(P0_, P1_, RT + (222 - (qlo + r32) + kb_ + 4 * hi)); } \
        else { if (kb_ + KVBLK - 1 > qlo) zero_tile(P0_, P1_, qm - kb_); } } while (0)
    constexpr int NQL = 8;
#define SEAM_K0() do { VMWN(NQL); SWRITE_HK(0); SBAR(); } while (0)
    f32x16 pA0, pA1, pB0, pB1; float mnA, mnB, alA, alB; bf16x8 pa0, pa1, pa2, pa3;
    SWRITE_HV(0); SBAR();
    SLOAD_H(Kh, Vh, KBASE(1));
    { CINIT(ci0, 0); SBAR(); qkt<0>(pA0, pA1, K_lds, r32, hi, S.qr, ci0); }
    MASKT(pA0, pA1, 0); partialSM<MODE>(pA0, pA1, m_reg, mnA, alA);
    VMW(); SWRITE_H(1);
    __syncthreads();
#define HALF_STEP(PX0, PX1, mnX, alX, PY0, PY1, alY, t, KB, VB, SB) do {                                                      \
        { CINIT(ci_, t); SBAR(); qkt<KB>(PX0, PX1, K_lds, r32, hi, S.qr, ci_); }                                              \
        finishSM<MODE>(PY0, PY1, alY, l_reg, pa0, pa1, pa2, pa3); SBAR();                                                     \
        if ((t) + 1 < NT) { SLOAD_H(Kh, Vh, KBASE((t) + 1)); SBAR(); }                                                        \
        pv_tile<VB>(o, vb0, pa0, pa1, pa2, pa3); MASKT(PX0, PX1, (t)); partialSM<MODE>(PX0, PX1, m_reg, mnX, alX);            \
        __syncthreads();                                                                                                      \
        if ((t) + 1 < NT) { VMW(); SWRITE_H(SB); }                                                                            \
        RESC(alX); __syncthreads(); } while (0)
    for (int t = 1; t + 1 < NT; t += 2) {
        HALF_STEP(pB0, pB1, mnB, alB, pA0, pA1, alA, t, 1, 0, 0);
        HALF_STEP(pA0, pA1, mnA, alA, pB0, pB1, alB, t + 1, 0, 1, 1);
    }
    { CINIT(ciL, NT - 1); SBAR(); qkt<1>(pB0, pB1, K_lds, r32, hi, S.qr, ciL); SBAR(); }
    SLOAD_H(nxt.K, nxt.V, 0); SBAR();
#pragma unroll
    for (int d0 = 0; d0 < 8; ++d0) S.qr[d0] = ld8(nxt.Q + (size_t)(wid * QBLK + r32) * D + d0 * 16 + hi * 8);
    SBAR();
    finishSM<MODE>(pA0, pA1, alA, l_reg, pa0, pa1, pa2, pa3); SBAR();
    pv_tile<0>(o, vb0, pa0, pa1, pa2, pa3);
    MASKT(pB0, pB1, NT - 1); partialSM<MODE>(pB0, pB1, m_reg, mnB, alB); __syncthreads(); RESC(alB);
    finishSM<MODE>(pB0, pB1, alB, l_reg, pa0, pa1, pa2, pa3); SBAR(); pv_tile<1>(o, vb0, pa0, pa1, pa2, pa3);
    SBAR(); SEAM_K0();
    float rli[16];
    if (MODE == 0) {
        if (hi == 0) li_l[r32] = l_reg; asm volatile("s_waitcnt lgkmcnt(0)" ::: "memory");
#pragma unroll
        for (int r = 0; r < 16; ++r) rli[r] = __builtin_amdgcn_rcpf(li_l[crow(r, hi)]);
    } else {
#pragma unroll
        for (int r = 0; r < 16; ++r) { float ss = (o[0][r] * o[0][r] + o[1][r] * o[1][r]) + (o[2][r] * o[2][r] + o[3][r] * o[3][r]);
            ss += shx<1>(ss); ss += shx<2>(ss); ss += shx<4>(ss); ss += shx<8>(ss); ss += shx<16>(ss);
            rli[r] = 1.0f / sqrtf(ss * (1.0f / 128.0f) + EPS); }
    }
    bf16_t* stg = (bf16_t*)(lds + OFF_STG) + wid * 4096;
#pragma unroll
    for (int r = 0; r < 16; ++r) { const int orow = crow(r, hi);
#pragma unroll
        for (int d0 = 0; d0 < 4; ++d0) { const float v = o[d0][r] * rli[r]; const float vn = shx<1>(v);
            if ((r32 & 1) == 0) *(unsigned*)(stg + orow * 128 + d0 * 32 + r32) = cvtpk(v, vn); } }
    asm volatile("s_waitcnt lgkmcnt(0)" ::: "memory");
#pragma unroll
    for (int i = 0; i < 8; ++i) { const int row = i * 4 + (lane >> 4), ch = lane & 15;
        const u32x4 ov = *(const u32x4*)(stg + row * 128 + ch * 8);
        const u32x4 zv = *(const u32x4*)(cur.Z + (size_t)(wid * QBLK + row) * D + ch * 8);
        u32x4 res;
#pragma unroll
        for (int e = 0; e < 4; ++e) res[e] = cvtpk(__uint_as_float(ov[e] << 16) * __uint_as_float(zv[e] << 16), __uint_as_float(ov[e] & 0xffff0000u) * __uint_as_float(zv[e] & 0xffff0000u));
        *(u32x4*)(cur.Y + (size_t)(wid * QBLK + row) * 2048 + ch * 8) = res; }
    __syncthreads();
#undef RESC
#undef KBASE
#undef CINIT
#undef MASKT
#undef SEAM_K0
#undef HALF_STEP
}
#undef ROW
#undef VMW
#undef VMWN
#undef SLOAD_H
#undef SWRITE_HK
#undef SWRITE_HV
#undef SWRITE_H
}

__device__ __forceinline__ void p2_attention(const Args& a, char* lds, int G) {
    unsigned char* ws = a.ws;
    const bf16_t* P = (const bf16_t*)(ws + WS_PROJ);
    bf16_t* Y = (bf16_t*)(ws + WS_Y);
    const int bx = blockIdx.x, vcu = (G % 8 == 0) ? (bx % 8) * (G / 8) + bx / 8 : bx;
    const int bh = vcu >> 3, k = vcu & 7, b = bh >> 3, h = bh & 7;
    const size_t hb = (size_t)bh * SEQ * 128;
    att::BlockRef u0, u1;
    u0.n = k; u0.h = h; u0.b = b;
    u0.Q = P + 0 * HM + hb + (size_t)k * 256 * 128; u0.K = P + 1 * HM + hb; u0.V = P + 2 * HM + hb; u0.Z = P + 3 * HM + hb + (size_t)k * 256 * 128;
    u0.Y = Y + (size_t)(b * SEQ + k * 256) * 2048 + h * 128;
    const int k1 = 7 - k;
    u1.n = k1; u1.h = h; u1.b = b;
    u1.Q = P + 4 * HM + hb + (size_t)k1 * 256 * 128; u1.K = P + 5 * HM + hb; u1.V = P + 6 * HM + hb; u1.Z = P + 7 * HM + hb + (size_t)k1 * 256 * 128;
    u1.Y = Y + (size_t)(b * SEQ + k1 * 256) * 2048 + 1024 + h * 128;
    att::Seam S;
    att::attn_prime(u0, lds, S);
    att::attn_block<0>(u0, u1, lds, S, (const float*)(ws + WS_KMEAN), a.in[10]);
    att::attn_block<1>(u1, u1, lds, S, nullptr, nullptr);
}

__global__ void __launch_bounds__(512, 2) mega_fwd(Args a) {
    extern __shared__ __attribute__((aligned(16))) unsigned char lds_raw[];
    LAS unsigned char* lds = (LAS unsigned char*)lds_raw;
    cg::grid_group grid = cg::this_grid();
    const int G = gridDim.x;
    unsigned char* ws = a.ws;

    p0_prologue(a, lds, G);
    grid.sync();

    {
        pg8::Gemm g{(const bf16_t*)(ws + WS_HBF), (const bf16_t*)(ws + WS_W1T), M, DIN, DM};
        pg8::StaticOrder S; S.init(M, DIN, G, (int)blockIdx.x);
        EpiProj E{(bf16_t*)(ws + WS_PROJ), (bf16_t*)(ws + WS_G), (float*)(ws + WS_KMEAN), (const float*)(ws + WS_CS)};
        pg8::gemm_phase<EpiProj, pg8::StaticOrder, true, true>(lds, g, S, E);
    }
    grid.sync();

    p2_attention(a, (char*)lds_raw, G);
    grid.sync();

    {
        pg8::Gemm g{(const bf16_t*)(ws + WS_Y), (const bf16_t*)(ws + WS_WABT), M, DM, DM};
        pg8::StaticOrder S; S.init(M, DM, G, (int)blockIdx.x);
        EpiMerge E{(const bf16_t*)(ws + WS_G), (bf16_t*)(ws + WS_MRG)};
        pg8::gemm_phase<EpiMerge, pg8::StaticOrder, true, true>(lds, g, S, E);
    }
    grid.sync();

    {
        pg8::Gemm g{(const bf16_t*)(ws + WS_MRG), (const bf16_t*)(ws + WS_WOT), M, DM, DM};
        pg8::StaticOrder S; S.init(M, DM, G, (int)blockIdx.x);
        EpiX1 E{a.in[0], a.out, (bf16_t*)(ws + WS_HBF), (float*)(ws + WS_SSQ1)};
        pg8::gemm_phase<EpiX1, pg8::StaticOrder, true, true>(lds, g, S, E);
    }
    grid.sync();

    {
        pg8::StaticOrder S; S.init(M, DM, G, (int)blockIdx.x);
        {
            pg8::Gemm g{(const bf16_t*)(ws + WS_PBF), (const bf16_t*)(ws + WS_WPPT), M, DM, DPLE};
            EpiPP E{(float*)(ws + WS_PPT)};
            pg8::gemm_phase<EpiPP, pg8::StaticOrder, true, true>(lds, g, S, E);
        }
        LAS float* rstd = (LAS float*)(lds + LDS_MISC + 1024);
        {
            Unit u; S.next(0, u);
            int tid = threadIdx.x; asm volatile("" : "+v"(tid));
            const int r = tid >> 1, hf = tid & 1;
            const f32x4* sp = (const f32x4*)((const float*)(ws + WS_SSQ1) + (size_t)(u.pm * 256 + r) * 32 + hf * 16);
            const f32x4 s0 = sp[0], s1 = sp[1], s2 = sp[2], s3 = sp[3];
            float ss = ((s0[0] + s0[1]) + (s0[2] + s0[3])) + ((s1[0] + s1[1]) + (s1[2] + s1[3])) + ((s2[0] + s2[1]) + (s2[2] + s2[3])) + ((s3[0] + s3[1]) + (s3[2] + s3[3]));
            ss += shx<1>(ss);
            if (hf == 0) rstd[r] = 1.0f / sqrtf(ss * (1.0f / DM) + EPS);
        }
        __syncthreads();
        {
            pg8::Gemm g{(const bf16_t*)(ws + WS_HBF), (const bf16_t*)(ws + WS_WPGT), M, DM, DM};
            EpiX2 E{(const float*)(ws + WS_PPT), a.out, (float*)(ws + WS_SSQ2), rstd};
            pg8::gemm_phase<EpiX2, pg8::StaticOrder, true, true>(lds, g, S, E);
        }
    }
    grid.sync();

    {
        int t__ = threadIdx.x; asm volatile("" : "+v"(t__));
        const int lane = t__ & 63, wave = __builtin_amdgcn_readfirstlane(t__ >> 6);
        const int gw = blockIdx.x * 8 + wave, NGW = G * 8;
        const float* ssq = (const float*)(ws + WS_SSQ2); const float* gf = a.in[11];
        for (int m = gw; m < M; m += NGW) {
            float ss = (lane < 32) ? ssq[(size_t)m * 32 + lane] : 0.f;
            ss = wave_sum(ss);
            const float rstd = 1.0f / sqrtf(ss * (1.0f / DM) + EPS);
            f32x4* xr = (f32x4*)(a.out + (size_t)m * DM) + lane;
#pragma unroll
            for (int j = 0; j < 8; ++j) { const f32x4 gv = ((const f32x4*)gf)[lane + 64 * j]; f32x4 v = xr[64 * j]; v = v * rstd * gv; xr[64 * j] = v; }
        }
    }
}

extern "C" void kernel_launch(void* const* d_in, const int* in_sizes, int n_in, void* d_out, int out_size, void* d_ws, size_t ws_size, hipStream_t stream) {
    static int grid = 0;
    if (grid == 0) {
        if (n_in != 12 || out_size != M * DM || ws_size < WS_END) { fprintf(stderr, "kernel_launch: unexpected problem shape (n_in %d out %d ws %zu)\n", n_in, out_size, ws_size); grid = -1; return; }
        int dev = 0, cus = 0, per_cu = 0;
        (void)hipGetDevice(&dev);
        (void)hipDeviceGetAttribute(&cus, hipDeviceAttributeMultiprocessorCount, dev);
        if (hipFuncSetAttribute((const void*)mega_fwd, hipFuncAttributeMaxDynamicSharedMemorySize, LDS_BYTES) != hipSuccess) { fprintf(stderr, "kernel_launch: hipFuncSetAttribute failed\n"); grid = -1; return; }
        if (hipOccupancyMaxActiveBlocksPerMultiprocessor(&per_cu, (const void*)mega_fwd, 512, LDS_BYTES) != hipSuccess || per_cu < 1) { fprintf(stderr, "kernel_launch: occupancy query failed (%d)\n", per_cu); (void)hipGetLastError(); per_cu = 1; }
        grid = cus * 1;
        if (grid != 256) { fprintf(stderr, "kernel_launch: %d CUs; this kernel needs exactly 256 workgroups (one 256x256 unit each in P3..P5)\n", grid); grid = -1; return; }
    }
    if (grid < 0) return;
    Args a{};
    for (int i = 0; i < 12; ++i) a.in[i] = (const float*)d_in[i];
    a.out = (float*)d_out; a.ws = (unsigned char*)d_ws;
    void* args[] = {&a};
    hipError_t e = hipLaunchCooperativeKernel((const void*)mega_fwd, dim3(grid), dim3(512), args, LDS_BYTES, stream);
    if (e != hipSuccess) fprintf(stderr, "kernel_launch: cooperative launch failed: %s (grid %d)\n", hipGetErrorString(e), grid);
}
```

```cpp
#include <hip/hip_runtime.h>
#include <cstdio>
#include <cstdint>

#define LAS __attribute__((address_space(3)))
typedef unsigned short bf16_t;
typedef short bf16x8 __attribute__((ext_vector_type(8)));
typedef float f32x4 __attribute__((ext_vector_type(4)));
typedef float f32x2 __attribute__((ext_vector_type(2)));
typedef unsigned u32x4 __attribute__((ext_vector_type(4)));
typedef unsigned u32x2 __attribute__((ext_vector_type(2)));

constexpr int NB = 4, SEQ = 2048, DM = 2048, M = NB * SEQ, DIN = 12288, NH = 8, DH = 128, LBLK = 256, DPLE = 256;
constexpr float EPS = 1e-6f, LOG2E = 1.4426950408889634f;
constexpr float QSCALE_A = 0.08838834764831845f * LOG2E;
constexpr float KSCALE_B = 0.08838834764831845f;

constexpr size_t MiB = 1u << 20;
constexpr size_t WS_BAR = 0;
constexpr size_t WS_KMEAN = 64 * 1024;
constexpr size_t WS_CS = 1 * MiB;
constexpr size_t WS_W1T = 2 * MiB;
constexpr size_t WS_WABT = 50 * MiB;
constexpr size_t WS_WOT = 58 * MiB;
constexpr size_t WS_WPGT = 66 * MiB;
constexpr size_t WS_WPPT = 74 * MiB;
constexpr size_t WS_PBF = 75 * MiB;
constexpr size_t WS_SSQ1 = 79 * MiB;
constexpr size_t WS_SSQ2 = 80 * MiB;
constexpr size_t WS_HBF = 82 * MiB;
constexpr size_t WS_Y = 114 * MiB;
constexpr size_t WS_MRG = 146 * MiB;
constexpr size_t WS_PROJ = 178 * MiB;
constexpr size_t WS_G = 306 * MiB;
constexpr size_t WS_PPT = 178 * MiB;
constexpr size_t WS_END = 370 * MiB;
constexpr size_t HM = (size_t)M * 1024;

constexpr int LDS_BYTES = 147456;
constexpr int LDS_MISC = 131072;

__device__ __forceinline__ float bf2f(unsigned short v) { return __uint_as_float((unsigned)v << 16); }
__device__ __forceinline__ unsigned f2bf(float f) { unsigned u = __float_as_uint(f); return (u + 0x7fffu + ((u >> 16) & 1u)) >> 16; }
__device__ __forceinline__ unsigned pk2(float lo, float hi) { return f2bf(lo) | (f2bf(hi) << 16); }
template <int MASK> __device__ __forceinline__ float shx(float v) {
    return __int_as_float(__builtin_amdgcn_ds_swizzle(__float_as_int(v), (MASK << 10) | 0x1f));
}
__device__ __forceinline__ float half_sum(float v) {
    auto rr = __builtin_amdgcn_permlane32_swap(__float_as_uint(v), __float_as_uint(v), false, false);
    return __uint_as_float(rr[0]) + __uint_as_float(rr[1]);
}
__device__ __forceinline__ float wave_sum(float v) {
    v += shx<1>(v); v += shx<2>(v); v += shx<4>(v); v += shx<8>(v); v += shx<16>(v);
    return half_sum(v);
}
__device__ __forceinline__ float fast_sigmoid(float v) { return __builtin_amdgcn_rcpf(1.0f + __builtin_amdgcn_exp2f(-v * LOG2E)); }
#define LDS_WAIT() asm volatile("s_waitcnt lgkmcnt(0)" ::: "memory")
#define OPAQUE_LANE_COORDS() int t__ = threadIdx.x; asm volatile("" : "+v"(t__)); const int wr = t__ >> 8, wc = (t__ >> 6) & 3, fr = t__ & 15, fq = (t__ >> 4) & 3

#define XB_TMO      128
#define XB_XCNT(j)  (256  + 64 * (j))
#define XB_XSUB(j)  (1280 + 64 * (j))
#define XB_XGEN(j)  (2304 + 64 * (j))
#define XB_TOP      3328
#define XB_TOPGEN   3392
#define XCD_BAR_WORDS 3456
#define XB_SPIN_CAP (1u << 18)
__device__ __forceinline__ unsigned xb_ld(unsigned* p)              { return __hip_atomic_load(p, __ATOMIC_RELAXED, __HIP_MEMORY_SCOPE_AGENT); }
__device__ __forceinline__ unsigned xb_add(unsigned* p, unsigned v) { return __hip_atomic_fetch_add(p, v, __ATOMIC_RELAXED, __HIP_MEMORY_SCOPE_AGENT); }
__device__ __forceinline__ unsigned xb_xcc_id() { return (unsigned)__builtin_amdgcn_s_getreg((3 << 11) | 20) & 0xFu; }
#define XB_SPIN(cond, bar) do { unsigned _sp = 0; while (cond) { __builtin_amdgcn_s_sleep(1); \
    if ((++_sp & 255u) == 0u) { if (xb_ld(&(bar)[XB_TMO])) break; if (_sp > XB_SPIN_CAP) { atomicAdd(&(bar)[XB_TMO], 1u); break; } } } } while (0)
struct XcdBarrier { unsigned* bar; unsigned x; volatile LAS unsigned* st; };
__device__ __forceinline__ XcdBarrier xcd_barrier_post(unsigned* bar, volatile LAS unsigned* st) {
    XcdBarrier b; b.bar = bar; b.x = xb_xcc_id(); b.st = st;
    if (threadIdx.x == 0) (void)xb_add(&bar[XB_XCNT(b.x)], 1u);
    return b;
}
__device__ __forceinline__ void xcd_barrier_complete(unsigned* bar, unsigned x, unsigned& nloc, unsigned& nx) {
    const unsigned G = gridDim.x * gridDim.y * gridDim.z;
    unsigned sum, cnt, mine, sp = 0u;
    for (;;) {
        sum = 0u; cnt = 0u; mine = 0u;
#pragma unroll
        for (unsigned j = 0; j < 16; ++j) { const unsigned c = xb_ld(&bar[XB_XCNT(j)]); sum += c; cnt += (c > 0u) ? 1u : 0u; mine = (j == x) ? c : mine; }
        if (sum == G) break;
        __builtin_amdgcn_s_sleep(1);
        if ((++sp & 255u) == 0u) { if (xb_ld(&bar[XB_TMO])) break; if (sp > XB_SPIN_CAP) { atomicAdd(&bar[XB_TMO], 1u); break; } }
    }
    nloc = mine > 0u ? mine : 1u; nx = cnt > 0u ? cnt : 1u;
}
__device__ __forceinline__ void xcd_barrier(const XcdBarrier& b) {
    asm volatile("s_waitcnt vmcnt(0)" ::: "memory");
    __syncthreads();
    if (threadIdx.x == 0) {
        unsigned* bar = b.bar;
        __builtin_amdgcn_s_waitcnt(0);
        unsigned nloc = b.st[0], nx = b.st[1];
        if (nloc == 0u) { xcd_barrier_complete(bar, b.x, nloc, nx); b.st[0] = nloc; b.st[1] = nx; }
        const unsigned old = xb_add(&bar[XB_XSUB(b.x)], 1u);
        const unsigned gen = old / nloc;
        if (old + 1u == (gen + 1u) * nloc) {
            __builtin_amdgcn_fence(__ATOMIC_RELEASE, "agent");
            asm volatile("s_waitcnt vmcnt(0)" ::: "memory");
            const unsigned og = xb_add(&bar[XB_TOP], 1u);
            const unsigned tg = og / nx;
            if (og + 1u == (tg + 1u) * nx) xb_add(&bar[XB_TOPGEN], 1u);
            else XB_SPIN(xb_ld(&bar[XB_TOPGEN]) == tg, bar);
            __builtin_amdgcn_fence(__ATOMIC_ACQUIRE, "agent");
            xb_add(&bar[XB_XGEN(b.x)], 1u);
            asm volatile("s_waitcnt vmcnt(0)" ::: "memory");
        } else {
            XB_SPIN(xb_ld(&bar[XB_XGEN(b.x)]) == gen, bar);
            __builtin_amdgcn_fence(__ATOMIC_ACQUIRE, "agent");
            asm volatile("s_waitcnt vmcnt(0)" ::: "memory");
        }
    }
    __syncthreads();
}

namespace pg8 {
constexpr int BM = 256, BK = 64, HALF = 128, HTB = HALF * BK * 2, STAGE_BYTES = 8 * HTB, NXCD = 8, WGM = 8;
__host__ __device__ __forceinline__ int lds_byte(int r, int c) { const int st = (r >> 4) * 2 + (c >> 5), rr = r & 15, cc = c & 31, ob = rr * 64 + cc * 2; return st * 1024 + (ob ^ (((ob >> 9) & 1) << 5)); }
__host__ __device__ __forceinline__ void stage_rc(int b, int& R, int& C) { const int st = b / 1024, sb = b % 1024, swz = sb ^ (((sb >> 9) & 1) << 5); R = (st >> 1) * 16 + swz / 64; C = (st & 1) * 32 + (swz % 64) / 2; }
__host__ __device__ __forceinline__ int perm32(int rho) { const int n = rho >> 4, i = rho & 15; return 8 * (i >> 2) + 4 * n + (i & 3); }
struct Unit { int pm, pn; };
struct Gemm { const bf16_t* A; const bf16_t* Bt; int M, N, K; };
struct StaticOrder {
    int nM, nN, nwg, G, c;
    __host__ __device__ void init(int M_, int N_, int G_, int c_) { nM = M_ / BM; nN = N_ / BM; nwg = nM * nN; G = G_; c = c_; }
    __host__ __device__ bool next(int i, Unit& u) const {
        const long L = (long)i * G + c; if (L >= nwg) return false;
        int wgid = (int)L; { const int q = nwg / NXCD, r = nwg % NXCD, xcd = wgid % NXCD, off = wgid / NXCD; wgid = (xcd < r ? xcd * (q + 1) : r * (q + 1) + (xcd - r) * q) + off; }
        const int nig = WGM * nN, gid = wgid / nig, fm = gid * WGM, gsz = (nM - fm) < WGM ? (nM - fm) : WGM;
        u.pm = fm + ((wgid % nig) % gsz); u.pn = (wgid % nig) / gsz; return true;
    }
};
__device__ __forceinline__ unsigned cvt_pk_bf16(float lo, float hi) { unsigned r; asm volatile("v_cvt_pk_bf16_f32 %0, %1, %2" : "=v"(r) : "v"(lo), "v"(hi)); return r; }

template <class Epi, class Sched, bool ALIGN_EPI, bool SP2>
__device__ __forceinline__ void gemm_phase(LAS unsigned char* lds, const Gemm g, const Sched& S, const Epi& E) {
    int tid = threadIdx.x; asm volatile("" : "+v"(tid));
    const int wid = __builtin_amdgcn_readfirstlane(tid >> 6), lane = tid & 63, wr = wid >> 2, wc = wid & 3, fr = lane & 15, fq = lane >> 4;
    const int K = g.K, nt = K / BK;
    unsigned voffA[2], voffB[2];
#pragma unroll
    for (int i = 0; i < 2; ++i) { int R, C; stage_rc(tid * 16 + i * 8192, R, C); const int Rb = Epi::PERM ? ((R & ~31) + perm32(R & 31)) : R;
        voffA[i] = (unsigned)(R * K + C) * 2u; voffB[i] = (unsigned)(Rb * K + C) * 2u; }
    const size_t kstep = (size_t)(BK * 2);
    const size_t hstep = (size_t)HALF * K * 2;
    const size_t tstep = 2 * hstep;
    const unsigned ldsw = (unsigned)wid * 1024u;
    const int aoff = lds_byte(wr * 64 + fr, fq * 8), boff = lds_byte(wc * 32 + fr, fq * 8);
#define PG8_SA(b, h) (((b) * 2 + (h)) * HTB)
#define PG8_SB(b, h) ((4 + (b) * 2 + (h)) * HTB)
#define PG8_STAGE(bufoff, gbase, voff) do { _Pragma("unroll") for (int _i = 0; _i < 2; ++_i) \
        __builtin_amdgcn_global_load_lds((const unsigned*)((const char*)(gbase) + (voff)[_i]), (LAS unsigned*)(lds + (bufoff) + ldsw + _i * 8192), 16, 0, 0); } while (0)
#define PG8_LDA(dst, b, h) do { _Pragma("unroll") for (int m = 0; m < 4; ++m) _Pragma("unroll") for (int k = 0; k < 2; ++k) dst[m][k] = *(const LAS bf16x8*)(lds + PG8_SA(b, h) + aoff + m * 2048 + k * 1024); } while (0)
#define PG8_LDB(dst, b, h) do { _Pragma("unroll") for (int n = 0; n < 2; ++n) _Pragma("unroll") for (int k = 0; k < 2; ++k) dst[n][k] = *(const LAS bf16x8*)(lds + PG8_SB(b, h) + boff + n * 2048 + k * 1024); } while (0)
#define PG8_MMA(ai, bj, At, Bt) do { __builtin_amdgcn_s_setprio(1); _Pragma("unroll") for (int m = 0; m < 4; ++m) _Pragma("unroll") for (int n = 0; n < 2; ++n) _Pragma("unroll") for (int k = 0; k < 2; ++k) \
        acc[ai][bj][m][n] = __builtin_amdgcn_mfma_f32_16x16x32_bf16(Bt[n][k], At[m][k], acc[ai][bj][m][n], 0, 0, 0); __builtin_amdgcn_s_setprio(0); } while (0)
#define PG8_WAIT_V(n) asm volatile("s_waitcnt vmcnt(" #n ")" ::: "memory")
#define PG8_WAIT_L(n) asm volatile("s_waitcnt lgkmcnt(" #n ")" ::: "memory")
#define PG8_BAR __builtin_amdgcn_s_barrier()
#define PG8_SCHED __builtin_amdgcn_sched_barrier(0)
    Unit cur, nxt; int ui = 0;
    if (!S.next(0, cur)) return;
    f32x4 acc[2][2][4][2];
#pragma unroll
    for (int a = 0; a < 2; ++a)
#pragma unroll
        for (int b = 0; b < 2; ++b)
#pragma unroll
            for (int m = 0; m < 4; ++m)
#pragma unroll
                for (int n = 0; n < 2; ++n) acc[a][b][m][n] = (f32x4){0.f, 0.f, 0.f, 0.f};
    bf16x8 At[4][2], B0[2][2], B1[2][2];
    const char* cA = (const char*)g.A + (size_t)cur.pm * tstep; const char* cB = (const char*)g.Bt + (size_t)cur.pn * tstep;
    if constexpr (SP2) {
        PG8_STAGE(PG8_SB(0, 0), cB, voffB); PG8_STAGE(PG8_SB(0, 1), cB + hstep, voffB); PG8_STAGE(PG8_SA(0, 0), cA, voffA); PG8_STAGE(PG8_SA(0, 1), cA + hstep, voffA);
        if (wr == 1) PG8_BAR;
        PG8_WAIT_V(2); PG8_BAR;
        PG8_STAGE(PG8_SB(1, 0), cB + kstep, voffB); PG8_STAGE(PG8_SA(1, 0), cA + kstep, voffA); PG8_STAGE(PG8_SB(1, 1), cB + hstep + kstep, voffB);
        PG8_WAIT_V(6); PG8_BAR;
    } else {
        PG8_STAGE(PG8_SB(0, 0), cB, voffB); PG8_STAGE(PG8_SA(0, 0), cA, voffA); PG8_STAGE(PG8_SB(0, 1), cB + hstep, voffB); PG8_STAGE(PG8_SA(0, 1), cA + hstep, voffA);
        if (wr == 1) PG8_BAR;
        PG8_WAIT_V(4); PG8_BAR;
        PG8_STAGE(PG8_SB(1, 0), cB + kstep, voffB); PG8_STAGE(PG8_SA(1, 0), cA + kstep, voffA); PG8_STAGE(PG8_SB(1, 1), cB + hstep + kstep, voffB);
        PG8_WAIT_V(6); PG8_BAR;
    }
    for (;;) {
        const bool has_next = S.next(ui + 1, nxt);
        const char* nA = has_next ? (const char*)g.A + (size_t)nxt.pm * tstep : cA; const char* nB = has_next ? (const char*)g.Bt + (size_t)nxt.pn * tstep : cB;
        for (int t = 0; t < nt; t += 2) {
            const bool last = (t == nt - 2);
            const char* a1 = cA + (size_t)(t + 1) * kstep;
            const char* a2 = last ? nA : cA + (size_t)(t + 2) * kstep; const char* b2 = last ? nB : cB + (size_t)(t + 2) * kstep;
            const char* a3 = a2 + kstep; const char* b3 = b2 + kstep;
            if constexpr (Epi::MID) { if (t == (nt >> 1)) E.mid(acc, cur, wr, wc, fr, fq); }
            if constexpr (SP2) {
            PG8_LDB(B0, 0, 0); PG8_LDB(B1, 0, 1); PG8_SCHED; PG8_LDA(At, 0, 0); PG8_STAGE(PG8_SA(1, 1), a1 + hstep, voffA);
            PG8_WAIT_V(8); PG8_WAIT_L(0); PG8_BAR; PG8_MMA(0, 0, At, B0); PG8_MMA(0, 1, At, B1); PG8_BAR; PG8_SCHED;
            PG8_LDA(At, 0, 1); PG8_STAGE(PG8_SB(0, 0), b2, voffB); PG8_STAGE(PG8_SB(0, 1), b2 + hstep, voffB); PG8_STAGE(PG8_SA(0, 0), a2, voffA);
            PG8_WAIT_V(8); PG8_WAIT_L(0); PG8_BAR; PG8_MMA(1, 0, At, B0); PG8_MMA(1, 1, At, B1); PG8_BAR; PG8_SCHED;
            PG8_LDB(B0, 1, 0); PG8_LDB(B1, 1, 1); PG8_SCHED; PG8_LDA(At, 1, 0); PG8_STAGE(PG8_SA(0, 1), a2 + hstep, voffA);
            PG8_WAIT_V(8); PG8_WAIT_L(0); PG8_BAR; PG8_MMA(0, 0, At, B0); PG8_MMA(0, 1, At, B1); PG8_BAR; PG8_SCHED;
            PG8_LDA(At, 1, 1); PG8_STAGE(PG8_SB(1, 0), b3, voffB); PG8_STAGE(PG8_SB(1, 1), b3 + hstep, voffB); PG8_STAGE(PG8_SA(1, 0), a3, voffA);
            PG8_WAIT_V(8); PG8_WAIT_L(0); PG8_BAR; PG8_MMA(1, 0, At, B0); PG8_MMA(1, 1, At, B1); PG8_BAR; PG8_SCHED;
            } else {
            PG8_LDB(B0, 0, 0); PG8_SCHED; PG8_LDA(At, 0, 0); PG8_STAGE(PG8_SA(1, 1), a1 + hstep, voffA);
            PG8_WAIT_L(8); PG8_BAR; PG8_WAIT_L(0); PG8_MMA(0, 0, At, B0); PG8_BAR; PG8_SCHED;
            PG8_LDB(B1, 0, 1); PG8_STAGE(PG8_SB(0, 0), b2, voffB);
            PG8_BAR; PG8_WAIT_L(0); PG8_MMA(0, 1, At, B1); PG8_BAR;
            PG8_LDA(At, 0, 1); PG8_STAGE(PG8_SA(0, 0), a2, voffA);
            PG8_BAR; PG8_WAIT_L(0); PG8_MMA(1, 0, At, B0); PG8_BAR; PG8_SCHED;
            PG8_STAGE(PG8_SB(0, 1), b2 + hstep, voffB);
            PG8_WAIT_V(6); PG8_BAR; PG8_MMA(1, 1, At, B1); PG8_BAR;
            PG8_LDB(B0, 1, 0); PG8_SCHED; PG8_LDA(At, 1, 0); PG8_STAGE(PG8_SA(0, 1), a2 + hstep, voffA);
            PG8_WAIT_L(8); PG8_BAR; PG8_WAIT_L(0); PG8_MMA(0, 0, At, B0); PG8_BAR; PG8_SCHED;
            PG8_LDB(B1, 1, 1); PG8_STAGE(PG8_SB(1, 0), b3, voffB);
            PG8_BAR; PG8_WAIT_L(0); PG8_MMA(0, 1, At, B1); PG8_BAR;
            PG8_LDA(At, 1, 1); PG8_STAGE(PG8_SA(1, 0), a3, voffA);
            PG8_BAR; PG8_WAIT_L(0); PG8_MMA(1, 0, At, B0); PG8_BAR; PG8_SCHED;
            PG8_STAGE(PG8_SB(1, 1), b3 + hstep, voffB);
            PG8_WAIT_V(6); PG8_BAR; PG8_MMA(1, 1, At, B1); PG8_BAR;
            }
        }
        if constexpr (ALIGN_EPI) { if (wr == 0) PG8_BAR; }
        E(acc, cur, wr, wc, fr, fq);
        if (!has_next) break;
#pragma unroll
        for (int a = 0; a < 2; ++a)
#pragma unroll
            for (int b = 0; b < 2; ++b)
#pragma unroll
                for (int m = 0; m < 4; ++m)
#pragma unroll
                    for (int n = 0; n < 2; ++n) acc[a][b][m][n] = (f32x4){0.f, 0.f, 0.f, 0.f};
        cur = nxt; cA = nA; cB = nB; ++ui;
        if constexpr (ALIGN_EPI) { if (wr == 1) PG8_BAR; }
    }
    PG8_WAIT_V(0);
    if constexpr (!ALIGN_EPI) { if (wr == 0) PG8_BAR; }
    PG8_BAR;
#undef PG8_SA
#undef PG8_SB
#undef PG8_STAGE
#undef PG8_LDA
#undef PG8_LDB
#undef PG8_MMA
#undef PG8_WAIT_V
#undef PG8_WAIT_L
#undef PG8_BAR
#undef PG8_SCHED
}
}

using pg8::Unit;
typedef f32x4 Acc[2][2][4][2];

struct EpiProj {
    static constexpr bool PERM = true, MID = false;
    bf16_t* proj; bf16_t* G; float* kmean; const float* cs;
    __device__ __forceinline__ void operator()(const Acc& acc, const Unit& u, int, int, int, int) const {
        OPAQUE_LANE_COORDS();
        const int seg = u.pn >> 2;
        if (seg >= 8) {
            const int row0 = u.pm * 256 + wr * 64 + fr, col0 = (u.pn - 32) * 256 + wc * 32 + 8 * fq;
#pragma unroll
            for (int ai = 0; ai < 2; ++ai)
#pragma unroll
                for (int m = 0; m < 4; ++m) { bf16_t* rowp = G + (size_t)(row0 + ai * 128 + m * 16) * 4096 + col0;
#pragma unroll
                    for (int bj = 0; bj < 2; ++bj) { const f32x4 v0 = acc[ai][bj][m][0], v1 = acc[ai][bj][m][1];
                        u32x4 w; w.x = pg8::cvt_pk_bf16(v0[0], v0[1]); w.y = pg8::cvt_pk_bf16(v0[2], v0[3]); w.z = pg8::cvt_pk_bf16(v1[0], v1[1]); w.w = pg8::cvt_pk_bf16(v1[2], v1[3]);
                        *(u32x4*)(rowp + bj * 128) = w; } }
            return;
        }
        bf16_t* base = proj + (size_t)seg * HM;
        const int b = u.pm >> 3, s0 = (u.pm & 7) * 256 + wr * 64 + fr, hq = (u.pn & 3) * 2, d0 = wc * 32 + 8 * fq;
        const bool rot = (seg == 4) || (seg == 5);
        float cs_[2][8];
#pragma unroll
        for (int bj = 0; bj < 2; ++bj)
#pragma unroll
            for (int i = 0; i < 8; ++i) cs_[bj][i] = 0.f;
#pragma unroll
        for (int ai = 0; ai < 2; ++ai)
#pragma unroll
            for (int m = 0; m < 4; ++m) {
                const int s = s0 + ai * 128 + m * 16;
                f32x4 c4 = (f32x4){1.f, 1.f, 1.f, 1.f}, s4 = (f32x4){0.f, 0.f, 0.f, 0.f};
                if (rot) { c4 = *(const f32x4*)(cs + (size_t)s * 64 + (d0 >> 1)); s4 = *(const f32x4*)(cs + (size_t)SEQ * 64 + (size_t)s * 64 + (d0 >> 1)); }
#pragma unroll
                for (int bj = 0; bj < 2; ++bj) {
                    f32x4 v0 = acc[ai][bj][m][0], v1 = acc[ai][bj][m][1];
                    if (seg == 0) { v0 = v0 * QSCALE_A; v1 = v1 * QSCALE_A; }
                    else if (seg == 1) {
#pragma unroll
                        for (int i = 0; i < 4; ++i) { cs_[bj][i] += v0[i]; cs_[bj][4 + i] += v1[i]; } }
                    else if (seg == 3 || seg == 7) {
#pragma unroll
                        for (int i = 0; i < 4; ++i) { v0[i] = v0[i] * fast_sigmoid(v0[i]); v1[i] = v1[i] * fast_sigmoid(v1[i]); } }
                    else if (rot) {
                        const float lg2 = log2f(1.0f - exp2f(-5.0f - (float)(hq + bj)));
                        const float sc = (seg == 5) ? KSCALE_B * __builtin_amdgcn_exp2f(-(float)s * lg2) : __builtin_amdgcn_exp2f((float)s * lg2);
                        f32x4 r0, r1;
                        r0[0] = (v0[0] * c4[0] - v0[1] * s4[0]) * sc; r0[1] = (v0[1] * c4[0] + v0[0] * s4[0]) * sc;
                        r0[2] = (v0[2] * c4[1] - v0[3] * s4[1]) * sc; r0[3] = (v0[3] * c4[1] + v0[2] * s4[1]) * sc;
                        r1[0] = (v1[0] * c4[2] - v1[1] * s4[2]) * sc; r1[1] = (v1[1] * c4[2] + v1[0] * s4[2]) * sc;
                        r1[2] = (v1[2] * c4[3] - v1[3] * s4[3]) * sc; r1[3] = (v1[3] * c4[3] + v1[2] * s4[3]) * sc;
                        v0 = r0; v1 = r1; }
                    u32x4 w; w.x = pg8::cvt_pk_bf16(v0[0], v0[1]); w.y = pg8::cvt_pk_bf16(v0[2], v0[3]); w.z = pg8::cvt_pk_bf16(v1[0], v1[1]); w.w = pg8::cvt_pk_bf16(v1[2], v1[3]);
                    *(u32x4*)(base + ((size_t)((b * 8 + hq + bj) * SEQ + s)) * 128 + d0) = w;
                }
            }
        if (seg == 1) {
#pragma unroll
            for (int bj = 0; bj < 2; ++bj)
#pragma unroll
                for (int i = 0; i < 8; ++i) { float v = cs_[bj][i]; v += shx<1>(v); v += shx<2>(v); v += shx<4>(v); v += shx<8>(v);
                    if (fr == 0) __hip_atomic_fetch_add(kmean + (size_t)u.pm * 1024 + (hq + bj) * 128 + d0 + i, v, __ATOMIC_RELAXED, __HIP_MEMORY_SCOPE_AGENT); }
        }
    }
};

struct EpiMerge {
    static constexpr bool PERM = true, MID = true;
    const bf16_t* G; bf16_t* out;
    __device__ __forceinline__ void mid(Acc& acc, const Unit& u, int, int, int, int) const {
        OPAQUE_LANE_COORDS();
        const int row0 = u.pm * 256 + wr * 64 + fr, col0 = u.pn * 256 + wc * 32 + 8 * fq;
#pragma unroll
        for (int ai = 0; ai < 2; ++ai)
#pragma unroll
            for (int m = 0; m < 4; ++m) { const bf16_t* gp = G + (size_t)(row0 + ai * 128 + m * 16) * 4096 + col0;
#pragma unroll
                for (int bj = 0; bj < 2; ++bj) { const u32x4 ga = *(const u32x4*)(gp + bj * 128), gb = *(const u32x4*)(gp + 2048 + bj * 128);
#pragma unroll
                    for (int i = 0; i < 4; ++i) {
                        const float a0 = __uint_as_float(ga[i] << 16), a1 = __uint_as_float(ga[i] & 0xffff0000u), b0 = __uint_as_float(gb[i] << 16), b1 = __uint_as_float(gb[i] & 0xffff0000u);
                        const float r0 = (1.0f + __builtin_amdgcn_exp2f(-b0 * LOG2E)) * __builtin_amdgcn_rcpf(1.0f + __builtin_amdgcn_exp2f(-a0 * LOG2E));
                        const float r1 = (1.0f + __builtin_amdgcn_exp2f(-b1 * LOG2E)) * __builtin_amdgcn_rcpf(1.0f + __builtin_amdgcn_exp2f(-a1 * LOG2E));
                        acc[ai][bj][m][i >> 1][(i & 1) * 2] *= r0; acc[ai][bj][m][i >> 1][(i & 1) * 2 + 1] *= r1; } } }
    }
    __device__ __forceinline__ void operator()(const Acc& acc, const Unit& u, int, int, int, int) const {
        OPAQUE_LANE_COORDS();
        const int row0 = u.pm * 256 + wr * 64 + fr, col0 = u.pn * 256 + wc * 32 + 8 * fq;
#pragma unroll
        for (int ai = 0; ai < 2; ++ai)
#pragma unroll
            for (int m = 0; m < 4; ++m) { const size_t row = (size_t)(row0 + ai * 128 + m * 16);
#pragma unroll
                for (int bj = 0; bj < 2; ++bj) { const u32x4 gb = *(const u32x4*)(G + row * 4096 + 2048 + col0 + bj * 128);
                    float o[8];
#pragma unroll
                    for (int i = 0; i < 4; ++i) { const float b0 = __uint_as_float(gb[i] << 16), b1 = __uint_as_float(gb[i] & 0xffff0000u);
                        o[2 * i] = acc[ai][bj][m][i >> 1][(i & 1) * 2] * fast_sigmoid(b0); o[2 * i + 1] = acc[ai][bj][m][i >> 1][(i & 1) * 2 + 1] * fast_sigmoid(b1); }
                    u32x4 w; w.x = pg8::cvt_pk_bf16(o[0], o[1]); w.y = pg8::cvt_pk_bf16(o[2], o[3]); w.z = pg8::cvt_pk_bf16(o[4], o[5]); w.w = pg8::cvt_pk_bf16(o[6], o[7]);
                    *(u32x4*)(out + row * 2048 + col0 + bj * 128) = w; } }
    }
};

struct EpiX1 {
    static constexpr bool PERM = false, MID = false;
    const float* x; float* x1; bf16_t* x1bf; float* ssq;
    __device__ __forceinline__ void operator()(const Acc& acc, const Unit& u, int, int, int, int) const {
        OPAQUE_LANE_COORDS();
        const int row0 = u.pm * 256 + wr * 64 + fr, col0 = u.pn * 256 + wc * 32 + 4 * fq;
#pragma unroll
        for (int ai = 0; ai < 2; ++ai)
#pragma unroll
            for (int m = 0; m < 4; ++m) { const size_t row = (size_t)(row0 + ai * 128 + m * 16); float ss = 0.f;
#pragma unroll
                for (int bj = 0; bj < 2; ++bj)
#pragma unroll
                    for (int n = 0; n < 2; ++n) { const size_t off = row * 2048 + col0 + bj * 128 + n * 16;
                        const f32x4 o = *(const f32x4*)(x + off) + acc[ai][bj][m][n];
                        *(f32x4*)(x1 + off) = o;
                        u32x2 w; w.x = pg8::cvt_pk_bf16(o[0], o[1]); w.y = pg8::cvt_pk_bf16(o[2], o[3]); *(u32x2*)(x1bf + off) = w;
                        ss += (o[0] * o[0] + o[1] * o[1]) + (o[2] * o[2] + o[3] * o[3]); }
                ss += shx<16>(ss); ss = half_sum(ss);
                if (fq == 0) ssq[row * 32 + u.pn * 4 + wc] = ss; }
    }
};
struct EpiPP {
    static constexpr bool PERM = false, MID = false;
    float* pp;
    __device__ __forceinline__ void operator()(const Acc& acc, const Unit& u, int, int, int, int) const {
        OPAQUE_LANE_COORDS();
        const int row0 = u.pm * 256 + wr * 64 + fr, col0 = u.pn * 256 + wc * 32 + 4 * fq;
#pragma unroll
        for (int ai = 0; ai < 2; ++ai)
#pragma unroll
            for (int m = 0; m < 4; ++m) { const size_t row = (size_t)(row0 + ai * 128 + m * 16);
#pragma unroll
                for (int bj = 0; bj < 2; ++bj)
#pragma unroll
                    for (int n = 0; n < 2; ++n) *(f32x4*)(pp + row * 2048 + col0 + bj * 128 + n * 16) = acc[ai][bj][m][n]; }
    }
};
struct EpiX2 {
    static constexpr bool PERM = false, MID = false;
    const float* pp; float* x1; float* ssq; const LAS float* rstd;
    __device__ __forceinline__ void operator()(const Acc& acc, const Unit& u, int, int, int, int) const {
        OPAQUE_LANE_COORDS();
        const int row0 = u.pm * 256 + wr * 64 + fr, col0 = u.pn * 256 + wc * 32 + 4 * fq;
#pragma unroll
        for (int ai = 0; ai < 2; ++ai)
#pragma unroll
            for (int m = 0; m < 4; ++m) { const size_t row = (size_t)(row0 + ai * 128 + m * 16); float ss = 0.f;
                const float rs = rstd[ai * 128 + wr * 64 + m * 16 + fr];
#pragma unroll
                for (int bj = 0; bj < 2; ++bj)
#pragma unroll
                    for (int n = 0; n < 2; ++n) { const size_t off = row * 2048 + col0 + bj * 128 + n * 16;
                        const f32x4 pv = *(const f32x4*)(pp + off), xv = *(const f32x4*)(x1 + off), a = acc[ai][bj][m][n];
                        f32x4 o;
#pragma unroll
                        for (int i = 0; i < 4; ++i) o[i] = xv[i] + fast_sigmoid(a[i] * rs) * pv[i];
                        *(f32x4*)(x1 + off) = o;
                        ss += (o[0] * o[0] + o[1] * o[1]) + (o[2] * o[2] + o[3] * o[3]); }
                ss += shx<16>(ss); ss = half_sum(ss);
                if (fq == 0) ssq[row * 32 + u.pn * 4 + wc] = ss; }
    }
};

struct Args { const float* in[12]; float* out; unsigned char* ws; };

__device__ __forceinline__ void p0_transpose_item(const float* W, int N, bf16_t* WT, int ldt, int coff, const float* sc, LAS float* scr, int item, int lane) {
    const int nblk = N / 32, kb = item / nblk, nb = item % nblk, k0 = 64 * kb, n0 = 32 * nb;
#pragma unroll 8
    for (int i = 0; i < 32; ++i) { const int kk = 2 * i + (lane >> 5); float v = W[(size_t)(k0 + kk) * N + n0 + (lane & 31)]; if (sc) v *= sc[k0 + kk]; scr[kk * 33 + (lane & 31)] = v; }
    LDS_WAIT();
    const int c = lane & 7;
#pragma unroll
    for (int j = 0; j < 4; ++j) { const int n = (lane >> 3) + 8 * j; const LAS float* s = scr + (8 * c) * 33 + n;
        u32x4 o; o.x = pk2(s[0 * 33], s[1 * 33]); o.y = pk2(s[2 * 33], s[3 * 33]); o.z = pk2(s[4 * 33], s[5 * 33]); o.w = pk2(s[6 * 33], s[7 * 33]);
        *(u32x4*)(WT + (size_t)(n0 + n) * ldt + coff + k0 + 8 * c) = o; }
    LDS_WAIT();
}
__device__ __forceinline__ void p0_prologue(const Args& a, LAS unsigned char* lds, int G) {
    int t__ = threadIdx.x; asm volatile("" : "+v"(t__));
    const int lane = t__ & 63, wave = __builtin_amdgcn_readfirstlane(t__ >> 6);
    unsigned char* ws = a.ws;
    LAS float* scr = (LAS float*)(lds + wave * 16384);
    const int gw = blockIdx.x * 8 + wave, NGW = G * 8;
    constexpr int I_IN = (DM / 64) * (DIN / 32), I_A = (1024 / 64) * (DM / 32), I_O = (DM / 64) * (DM / 32), I_PP = (DPLE / 64) * (DM / 32);
    constexpr int NITEMS = I_IN + 2 * I_A + 2 * I_O + I_PP;
    for (int it = gw; it < NITEMS; it += NGW) {
        int r = it;
        if (r < I_IN) { p0_transpose_item(a.in[3], DIN, (bf16_t*)(ws + WS_W1T), DM, 0, nullptr, scr, r, lane); continue; } r -= I_IN;
        if (r < I_A) { p0_transpose_item(a.in[4], DM, (bf16_t*)(ws + WS_WABT), DM, 0, nullptr, scr, r, lane); continue; } r -= I_A;
        if (r < I_A) { p0_transpose_item(a.in[5], DM, (bf16_t*)(ws + WS_WABT), DM, 1024, nullptr, scr, r, lane); continue; } r -= I_A;
        if (r < I_O) { p0_transpose_item(a.in[6], DM, (bf16_t*)(ws + WS_WOT), DM, 0, nullptr, scr, r, lane); continue; } r -= I_O;
        if (r < I_O) { p0_transpose_item(a.in[8], DM, (bf16_t*)(ws + WS_WPGT), DM, 0, a.in[7], scr, r, lane); continue; } r -= I_O;
        p0_transpose_item(a.in[9], DM, (bf16_t*)(ws + WS_WPPT), DPLE, 0, nullptr, scr, r, lane);
    }
    const float* x = a.in[0]; const float* p = a.in[1]; const float* g = a.in[2];
    bf16_t* hb = (bf16_t*)(ws + WS_HBF); bf16_t* pb = (bf16_t*)(ws + WS_PBF);
    for (int m = gw; m < M; m += NGW) {
        const f32x4* xr = (const f32x4*)(x + (size_t)m * DM) + lane;
        f32x4 v[8]; float ss = 0.f;
#pragma unroll
        for (int j = 0; j < 8; ++j) { v[j] = xr[64 * j]; ss += (v[j][0] * v[j][0] + v[j][1] * v[j][1]) + (v[j][2] * v[j][2] + v[j][3] * v[j][3]); }
        const float rstd = 1.0f / sqrtf(wave_sum(ss) * (1.0f / DM) + EPS);
        u32x2* o8 = (u32x2*)(hb + (size_t)m * DM) + lane;
#pragma unroll
        for (int j = 0; j < 8; ++j) { const f32x4 gv = ((const f32x4*)g)[lane + 64 * j]; u32x2 w; w.x = pk2(v[j][0] * rstd * gv[0], v[j][1] * rstd * gv[1]); w.y = pk2(v[j][2] * rstd * gv[2], v[j][3] * rstd * gv[3]); o8[64 * j] = w; }
        const f32x4 pv = ((const f32x4*)(p + (size_t)m * DPLE))[lane];
        u32x2 w; w.x = pk2(pv[0], pv[1]); w.y = pk2(pv[2], pv[3]); ((u32x2*)(pb + (size_t)m * DPLE))[lane] = w;
    }
    float* cs = (float*)(ws + WS_CS);
    for (int s = gw; s < SEQ; s += NGW) {
        const float theta = 1.0f / powf(10000.0f, (float)lane / 63.0f);
        const float ang = (float)s * theta;
        cs[(size_t)s * 64 + lane] = cosf(ang); cs[(size_t)SEQ * 64 + (size_t)s * 64 + lane] = sinf(ang);
    }
    float* km = (float*)(ws + WS_KMEAN);
    for (int i = gw * 64 + lane; i < 32 * 1024; i += NGW * 64) km[i] = 0.f;
}

namespace att {
typedef short s16x4 __attribute__((ext_vector_type(4)));
typedef float f32x16 __attribute__((ext_vector_type(16)));
constexpr int NW = 8, QBLK = 32, KVBLK = 64, D = 128;
constexpr int SHM_V = KVBLK * D * 2, SHM_K = KVBLK * D * 2;
constexpr int OFF_WS = 2 * SHM_V + 2 * SHM_K;
constexpr int OFF_STG = OFF_WS + NW * 64 * 4;
constexpr int OFF_TAB = OFF_STG + NW * 8192;
static_assert(OFF_TAB + 480 * 4 <= LDS_BYTES, "attention LDS map");
constexpr float THR = 8.f;

#define KSWZ(row, colB) ((row) * 256 + ((colB) ^ (((row) & 7) << 4)))
#define SBAR() __builtin_amdgcn_sched_barrier(0)
__device__ __forceinline__ int v_st(int k, int c) { const int kk = (k & ~0xC) | ((k & 4) << 1) | ((k & 8) >> 1); return ((kk >> 3) * 4 + (c >> 5)) * 512 + ((kk & 7) * 32 + (c & 31)) * 2; }
__device__ __forceinline__ int v_rd_base(int lane) { return ((lane & 3) << 3) | (((lane >> 2) & 3) << 6) | (((lane >> 4) & 1) << 5) | (((lane >> 5) & 1) << 8); }
constexpr int v_rd_off(int d0, int ks, int half) { return d0 * 512 + ks * 4096 + half * 2048; }
__device__ __forceinline__ int crow(int r, int hi) { return (r & 3) + 8 * (r >> 2) + 4 * hi; }
__device__ __forceinline__ unsigned cvtpk(float lo, float hi) { unsigned r; asm volatile("v_cvt_pk_bf16_f32 %0, %1, %2" : "=v"(r) : "v"(lo), "v"(hi)); return r; }
__device__ __forceinline__ bf16x8 ld8(const bf16_t* p) { return *reinterpret_cast<const bf16x8*>(p); }
__device__ __forceinline__ int t5_bucket(int n) {
    if (n < 16) return n;
    const float v = logf((float)n / 16.0f) / logf(8.0f) * 16.0f;
    const int l = 16 + (int)v;
    return l < 31 ? l : 31;
}
__device__ __forceinline__ void zero_tile(f32x16& p0, f32x16& p1, int dq) {
#pragma unroll
    for (int r = 0; r < 16; ++r) { const int c = (r & 3) + 8 * (r >> 2); if (dq - c < 0) p0[r] = 0.f; if (dq - c - 32 < 0) p1[r] = 0.f; }
}
__device__ __forceinline__ void bias_tile(f32x16& p0, f32x16& p1, const float* tp) {
#pragma unroll
    for (int r = 0; r < 16; ++r) { const int c = (r & 3) + 8 * (r >> 2); p0[r] += tp[c]; p1[r] += tp[c + 32]; }
}
template <int MODE> __device__ __forceinline__ void partialSM(f32x16& p0, f32x16& p1, float& m_reg, float& mn, float& alpha) {
    if (MODE == 1) { mn = 0.f; alpha = 1.f; return; }
    float pmax = p0[0];
#pragma unroll
    for (int r = 1; r < 16; ++r) pmax = fmaxf(pmax, p0[r]);
#pragma unroll
    for (int r = 0; r < 16; ++r) pmax = fmaxf(pmax, p1[r]);
    { auto rr = __builtin_amdgcn_permlane32_swap(__float_as_uint(pmax), __float_as_uint(pmax), false, false); pmax = fmaxf(__uint_as_float(rr[0]), __uint_as_float(rr[1])); }
    if (__builtin_expect(__all((pmax - m_reg) <= THR), 1)) { mn = m_reg; alpha = 1.f; }
    else { mn = fmaxf(m_reg, pmax); alpha = __builtin_amdgcn_exp2f(m_reg - mn); m_reg = mn; }
#pragma unroll
    for (int r = 0; r < 16; ++r) p0[r] = p0[r] - mn;
#pragma unroll
    for (int r = 0; r < 16; ++r) p1[r] = p1[r] - mn;
#pragma unroll
    for (int r = 0; r < 16; ++r) p0[r] = __builtin_amdgcn_exp2f(p0[r]);
}
template <int MODE> __device__ __forceinline__ void finishSM(f32x16& p0, f32x16& p1, float alpha, float& l_reg, bf16x8& pa0, bf16x8& pa1, bf16x8& pa2, bf16x8& pa3) {
    if (MODE == 0) {
#pragma unroll
        for (int r = 0; r < 16; ++r) p1[r] = __builtin_amdgcn_exp2f(p1[r]);
        float ps = 0;
#pragma unroll
        for (int r = 0; r < 16; ++r) ps += p0[r];
#pragma unroll
        for (int r = 0; r < 16; ++r) ps += p1[r];
        { auto rr = __builtin_amdgcn_permlane32_swap(__float_as_uint(ps), __float_as_uint(ps), false, false); ps = __uint_as_float(rr[0]) + __uint_as_float(rr[1]); }
        l_reg = l_reg * alpha + ps;
    }
#define PK4(P, B_, OUT) do { unsigned a0 = cvtpk(P[B_+0], P[B_+1]), a1 = cvtpk(P[B_+2], P[B_+3]);                          \
        unsigned b0 = cvtpk(P[B_+4], P[B_+5]), b1 = cvtpk(P[B_+6], P[B_+7]);                                             \
        auto r0 = __builtin_amdgcn_permlane32_swap(a0, b0, false, false); auto r1 = __builtin_amdgcn_permlane32_swap(a1, b1, false, false); \
        u32x4 w = {r0[0], r1[0], r0[1], r1[1]}; OUT = *reinterpret_cast<bf16x8*>(&w); } while (0)
    PK4(p0, 0, pa0); PK4(p0, 8, pa1); PK4(p1, 0, pa2); PK4(p1, 8, pa3);
#undef PK4
}
template <int KB>
__device__ __forceinline__ void qkt(f32x16& p0, f32x16& p1, const char* K_lds, int r32, int hi, const bf16x8* qr, float ci) {
#pragma unroll
    for (int r = 0; r < 16; ++r) { p0[r] = ci; p1[r] = ci; }
    const char* kb[4];
#pragma unroll
    for (int dd = 0; dd < 4; ++dd) kb[dd] = K_lds + KB * SHM_K + KSWZ(r32, (dd * 16 + hi * 8) * 2);
#pragma unroll
    for (int d0 = 0; d0 < 8; ++d0) { const char* a = kb[d0 & 3] + (d0 >> 2) * 128;
        bf16x8 b0 = *reinterpret_cast<const bf16x8*>(a);
        bf16x8 b1 = *reinterpret_cast<const bf16x8*>(a + 32 * 256);
        p0 = __builtin_amdgcn_mfma_f32_32x32x16_bf16(b0, qr[d0], p0, 0, 0, 0);
        p1 = __builtin_amdgcn_mfma_f32_32x32x16_bf16(b1, qr[d0], p1, 0, 0, 0); }
}
template <int VB>
__device__ __forceinline__ void pv_tile(f32x16* o, int vb0, bf16x8 pa0, bf16x8 pa1, bf16x8 pa2, bf16x8 pa3) {
#define TRRD(dst, off) asm volatile("ds_read_b64_tr_b16 %0, %1 offset:%2" : "=&v"(dst) : "v"(vb0), "i"(off) : "memory")
#define PV_D0(d0) do { s16x4 l0, l1, l2, l3, h0, h1, h2, h3; constexpr int b_ = VB * SHM_V + v_rd_off(d0, 0, 0); \
        TRRD(l0, b_); TRRD(h0, b_ + 2048); TRRD(l1, b_ + 4096); TRRD(h1, b_ + 6144); TRRD(l2, b_ + 8192); TRRD(h2, b_ + 10240); TRRD(l3, b_ + 12288); TRRD(h3, b_ + 14336); \
        asm volatile("s_waitcnt lgkmcnt(0)" ::: "memory"); SBAR(); \
        o[d0] = __builtin_amdgcn_mfma_f32_32x32x16_bf16(pa0, (bf16x8){l0[0], l0[1], l0[2], l0[3], h0[0], h0[1], h0[2], h0[3]}, o[d0], 0, 0, 0);   \
        o[d0] = __builtin_amdgcn_mfma_f32_32x32x16_bf16(pa1, (bf16x8){l1[0], l1[1], l1[2], l1[3], h1[0], h1[1], h1[2], h1[3]}, o[d0], 0, 0, 0);   \
        o[d0] = __builtin_amdgcn_mfma_f32_32x32x16_bf16(pa2, (bf16x8){l2[0], l2[1], l2[2], l2[3], h2[0], h2[1], h2[2], h2[3]}, o[d0], 0, 0, 0);   \
        o[d0] = __builtin_amdgcn_mfma_f32_32x32x16_bf16(pa3, (bf16x8){l3[0], l3[1], l3[2], l3[3], h3[0], h3[1], h3[2], h3[3]}, o[d0], 0, 0, 0); } while (0)
    PV_D0(0); PV_D0(1); PV_D0(2); PV_D0(3);
#undef PV_D0
#undef TRRD
}

struct BlockRef { const bf16_t* Q; const bf16_t* K; const bf16_t* V; const bf16_t* Z; bf16_t* Y; int n, h, b; };
struct Seam { bf16x8 qr[8]; bf16x8 st_v0, st_v1, st_k0, st_k1; };
#define ROW(p, k0, rr) ((p) + (size_t)((k0) + (rr)) * D + sc)
#define VMW() asm volatile("s_waitcnt vmcnt(0)" ::: "memory")
#define VMWN(n) asm volatile("s_waitcnt vmcnt(%0)" :: "i"(n) : "memory")
#define SLOAD_H(Kp, Vp, k0) do { S.st_v0 = ld8(ROW(Vp, k0, sr)); S.st_v1 = ld8(ROW(Vp, k0, 32 + sr)); S.st_k0 = ld8(ROW(Kp, k0, sr)); S.st_k1 = ld8(ROW(Kp, k0, 32 + sr)); } while (0)
#define SWRITE_HK(bf) do { *(bf16x8*)(K_lds + (bf) * SHM_K + kws) = S.st_k0; *(bf16x8*)(K_lds + (bf) * SHM_K + kws + 32 * 256) = S.st_k1; } while (0)
#define SWRITE_HV(bf) do { *(bf16x8*)(V_lds + (bf) * SHM_V + vst0) = S.st_v0; *(bf16x8*)(V_lds + (bf) * SHM_V + vst1) = S.st_v1; } while (0)
#define SWRITE_H(bf) do { SWRITE_HV(bf); SWRITE_HK(bf); } while (0)
__device__ __forceinline__ void attn_prime(const BlockRef& cur, char* lds, Seam& S) {
    const int tid = threadIdx.x, wid = __builtin_amdgcn_readfirstlane(tid >> 6), lane = tid & 63, r32 = lane & 31, hi = lane >> 5;
    const int sr = tid >> 4, sc = (tid & 15) * 8, kws = KSWZ(sr, sc * 2); char* K_lds = lds + 2 * SHM_V;
#pragma unroll
    for (int d0 = 0; d0 < 8; ++d0) S.qr[d0] = ld8(cur.Q + (size_t)(wid * QBLK + r32) * D + d0 * 16 + hi * 8);
    SLOAD_H(cur.K, cur.V, 0); VMW(); SWRITE_HK(0);
    __syncthreads();
}
template <int MODE>
__device__ __forceinline__ void attn_block(const BlockRef& cur, const BlockRef& nxt, char* lds, Seam& S, const float* kmsum, const float* rel_bias) {
    const int tid = threadIdx.x, wid = __builtin_amdgcn_readfirstlane(tid >> 6), lane = tid & 63, r32 = lane & 31, hi = lane >> 5;
    const int n = cur.n, NT = 4 * n + 4;
    const int qlo = n * 256 + wid * QBLK, qm = qlo + r32 - 4 * hi;
    char* V_lds = lds; char* K_lds = lds + 2 * SHM_V;
    float* ws = (float*)(lds + OFF_WS) + wid * 64; float* li_l = ws, * al_l = ws + 32;
    float m_reg = -1e30f, l_reg = 0; f32x16 o[4] = {};
    const int sr = tid >> 4, sc = (tid & 15) * 8, vst0 = v_st(sr, sc), vst1 = v_st(32 + sr, sc), kws = KSWZ(sr, sc * 2);
    const int vb0 = (int)(uintptr_t)V_lds + v_rd_base(lane);
    const bf16_t* Kh = cur.K; const bf16_t* Vh = cur.V;
    const float NEG = -__builtin_inff();
    unsigned selbits = 0u; float b31 = 0.f; const float* RT = (const float*)(lds + OFF_TAB);
    if (MODE == 0) {
        char* KM = lds + OFF_STG;
        { const int row = tid >> 6, c2 = (tid & 63) * 2;
          const float* kp = kmsum + (size_t)(cur.b * 8 + row) * 1024 + cur.h * 128 + c2;
          *(unsigned*)(KM + KSWZ(row, c2 * 2)) = pk2(kp[0] * (1.0f / 256.0f), kp[1] * (1.0f / 256.0f)); }
        if (tid < 480) { const int dist = 222 - tid; float v = NEG; if (dist >= 0) v = rel_bias[t5_bucket(dist < 128 ? dist : 128) * NH + cur.h] * LOG2E; ((float*)(lds + OFF_TAB))[tid] = v; }
        b31 = rel_bias[31 * NH + cur.h] * LOG2E;
        __syncthreads();
        f32x16 g = {};
#pragma unroll
        for (int d0 = 0; d0 < 8; ++d0) g = __builtin_amdgcn_mfma_f32_32x32x16_bf16(*reinterpret_cast<const bf16x8*>(KM + KSWZ(r32, d0 * 32 + hi * 16)), S.qr[d0], g, 0, 0, 0);
        float gt[8];
#pragma unroll
        for (int j = 0; j < 4; ++j) { auto rr = __builtin_amdgcn_permlane32_swap(__float_as_uint(g[j]), __float_as_uint(g[j]), false, false); gt[j] = __uint_as_float(rr[0]); gt[4 + j] = __uint_as_float(rr[1]); }
#pragma unroll
        for (int j = 0; j < 8; ++j) { int rank = 0;
#pragma unroll
            for (int k = 0; k < 8; ++k) if (k != j) rank += (k < n && (gt[k] > gt[j] || (gt[k] == gt[j] && k < j))) ? 1 : 0;
            if (j < n && rank < 3) selbits |= 1u << j; }
    }
#define RESC(a) do { if (MODE == 0) { if (__any((a) < 1.f)) { if (hi == 0) al_l[r32] = (a); asm volatile("s_waitcnt lgkmcnt(0)" ::: "memory");              \
                     for (int d_ = 0; d_ < 4; ++d_) for (int r = 0; r < 16; ++r) o[d_][r] *= al_l[crow(r, hi)]; } } } while (0)
#define KBASE(t) ((t) * KVBLK)
#define CINIT(var, t) float var = 0.f; if (MODE == 0) { const int kb_ = KBASE(t), j_ = (t) >> 2; var = (qlo - kb_ - 63 >= 128) ? b31 : 0.f; if (j_ < n && !((selbits >> j_) & 1u)) var = NEG; }
#define MASKT(P0_, P1_, t) do { const int kb_ = KBASE(t); \
        if (MODE == 0) { if (qlo - kb_ - 63 < 128) bias_tile(P0_, P1_, RT + (222 - (qlo + r32) + kb_ + 4 * hi)); } \
        else { if (kb_ + KVBLK - 1 > qlo) zero_tile(P0_, P1_, qm - kb_); } } while (0)
    constexpr int NQL = 8;
#define SEAM_K0() do { VMWN(NQL); SWRITE_HK(0); SBAR(); } while (0)
    f32x16 pA0, pA1, pB0, pB1; float mnA, mnB, alA, alB; bf16x8 pa0, pa1, pa2, pa3;
    SWRITE_HV(0); SBAR();
    SLOAD_H(Kh, Vh, KBASE(1));
    { CINIT(ci0, 0); SBAR(); qkt<0>(pA0, pA1, K_lds, r32, hi, S.qr, ci0); }
    MASKT(pA0, pA1, 0); partialSM<MODE>(pA0, pA1, m_reg, mnA, alA);
    VMW(); SWRITE_H(1);
    __syncthreads();
#define HALF_STEP(PX0, PX1, mnX, alX, PY0, PY1, alY, t, KB, VB, SB) do {                                                      \
        { CINIT(ci_, t); SBAR(); qkt<KB>(PX0, PX1, K_lds, r32, hi, S.qr, ci_); }                                              \
        finishSM<MODE>(PY0, PY1, alY, l_reg, pa0, pa1, pa2, pa3); SBAR();                                                     \
        if ((t) + 1 < NT) { SLOAD_H(Kh, Vh, KBASE((t) + 1)); SBAR(); }                                                        \
        pv_tile<VB>(o, vb0, pa0, pa1, pa2, pa3); MASKT(PX0, PX1, (t)); partialSM<MODE>(PX0, PX1, m_reg, mnX, alX);            \
        __syncthreads();                                                                                                      \
        if ((t) + 1 < NT) { VMW(); SWRITE_H(SB); }                                                                            \
        RESC(alX); __syncthreads(); } while (0)
    for (int t = 1; t + 1 < NT; t += 2) {
        HALF_STEP(pB0, pB1, mnB, alB, pA0, pA1, alA, t, 1, 0, 0);
        HALF_STEP(pA0, pA1, mnA, alA, pB0, pB1, alB, t + 1, 0, 1, 1);
    }
    { CINIT(ciL, NT - 1); SBAR(); qkt<1>(pB0, pB1, K_lds, r32, hi, S.qr, ciL); SBAR(); }
    SLOAD_H(nxt.K, nxt.V, 0); SBAR();
#pragma unroll
    for (int d0 = 0; d0 < 8; ++d0) S.qr[d0] = ld8(nxt.Q + (size_t)(wid * QBLK + r32) * D + d0 * 16 + hi * 8);
    SBAR();
    finishSM<MODE>(pA0, pA1, alA, l_reg, pa0, pa1, pa2, pa3); SBAR();
    pv_tile<0>(o, vb0, pa0, pa1, pa2, pa3);
    MASKT(pB0, pB1, NT - 1); partialSM<MODE>(pB0, pB1, m_reg, mnB, alB); __syncthreads(); RESC(alB);
    finishSM<MODE>(pB0, pB1, alB, l_reg, pa0, pa1, pa2, pa3); SBAR(); pv_tile<1>(o, vb0, pa0, pa1, pa2, pa3);
    SBAR(); SEAM_K0();
    float rli[16];
    if (MODE == 0) {
        if (hi == 0) li_l[r32] = l_reg; asm volatile("s_waitcnt lgkmcnt(0)" ::: "memory");
#pragma unroll
        for (int r = 0; r < 16; ++r) rli[r] = __builtin_amdgcn_rcpf(li_l[crow(r, hi)]);
    } else {
#pragma unroll
        for (int r = 0; r < 16; ++r) { float ss = (o[0][r] * o[0][r] + o[1][r] * o[1][r]) + (o[2][r] * o[2][r] + o[3][r] * o[3][r]);
            ss += shx<1>(ss); ss += shx<2>(ss); ss += shx<4>(ss); ss += shx<8>(ss); ss += shx<16>(ss);
            rli[r] = 1.0f / sqrtf(ss * (1.0f / 128.0f) + EPS); }
    }
    bf16_t* stg = (bf16_t*)(lds + OFF_STG) + wid * 4096;
#pragma unroll
    for (int r = 0; r < 16; ++r) { const int orow = crow(r, hi);
#pragma unroll
        for (int d0 = 0; d0 < 4; ++d0) { const float v = o[d0][r] * rli[r]; const float vn = shx<1>(v);
            if ((r32 & 1) == 0) *(unsigned*)(stg + orow * 128 + d0 * 32 + r32) = cvtpk(v, vn); } }
    asm volatile("s_waitcnt lgkmcnt(0)" ::: "memory");
#pragma unroll
    for (int i = 0; i < 8; ++i) { const int row = i * 4 + (lane >> 4), ch = lane & 15;
        const u32x4 ov = *(const u32x4*)(stg + row * 128 + ch * 8);
        const u32x4 zv = *(const u32x4*)(cur.Z + (size_t)(wid * QBLK + row) * D + ch * 8);
        u32x4 res;
#pragma unroll
        for (int e = 0; e < 4; ++e) res[e] = cvtpk(__uint_as_float(ov[e] << 16) * __uint_as_float(zv[e] << 16), __uint_as_float(ov[e] & 0xffff0000u) * __uint_as_float(zv[e] & 0xffff0000u));
        *(u32x4*)(cur.Y + (size_t)(wid * QBLK + row) * 2048 + ch * 8) = res; }
    __syncthreads();
#undef RESC
#undef KBASE
#undef CINIT
#undef MASKT
#undef SEAM_K0
#undef HALF_STEP
}
#undef ROW
#undef VMW
#undef VMWN
#undef SLOAD_H
#undef SWRITE_HK
#undef SWRITE_HV
#undef SWRITE_H
}

__device__ __forceinline__ void p2_attention(const Args& a, char* lds, int G) {
    unsigned char* ws = a.ws;
    const bf16_t* P = (const bf16_t*)(ws + WS_PROJ);
    bf16_t* Y = (bf16_t*)(ws + WS_Y);
    const int bx = blockIdx.x, vcu = (G % 8 == 0) ? (bx % 8) * (G / 8) + bx / 8 : bx;
    const int bh = vcu >> 3, k = vcu & 7, b = bh >> 3, h = bh & 7;
    const size_t hb = (size_t)bh * SEQ * 128;
    att::BlockRef u0, u1;
    u0.n = k; u0.h = h; u0.b = b;
    u0.Q = P + 0 * HM + hb + (size_t)k * 256 * 128; u0.K = P + 1 * HM + hb; u0.V = P + 2 * HM + hb; u0.Z = P + 3 * HM + hb + (size_t)k * 256 * 128;
    u0.Y = Y + (size_t)(b * SEQ + k * 256) * 2048 + h * 128;
    const int k1 = 7 - k;
    u1.n = k1; u1.h = h; u1.b = b;
    u1.Q = P + 4 * HM + hb + (size_t)k1 * 256 * 128; u1.K = P + 5 * HM + hb; u1.V = P + 6 * HM + hb; u1.Z = P + 7 * HM + hb + (size_t)k1 * 256 * 128;
    u1.Y = Y + (size_t)(b * SEQ + k1 * 256) * 2048 + 1024 + h * 128;
    att::Seam S;
    att::attn_prime(u0, lds, S);
    att::attn_block<0>(u0, u1, lds, S, (const float*)(ws + WS_KMEAN), a.in[10]);
    att::attn_block<1>(u1, u1, lds, S, nullptr, nullptr);
}

__global__ void __launch_bounds__(512, 2) mega_fwd(Args a) {
    extern __shared__ __attribute__((aligned(16))) unsigned char lds_raw[];
    LAS unsigned char* lds = (LAS unsigned char*)lds_raw;
    const int G = gridDim.x;
    unsigned char* ws = a.ws;
    volatile LAS unsigned* bst = (volatile LAS unsigned*)(lds + LDS_BYTES - 64);
    if (threadIdx.x < 2) bst[threadIdx.x] = 0u;
    __syncthreads();
    const XcdBarrier gbar = xcd_barrier_post((unsigned*)ws, bst);
#define GRID_SYNC() xcd_barrier(gbar)

    p0_prologue(a, lds, G);
    GRID_SYNC();

    {
        pg8::Gemm g{(const bf16_t*)(ws + WS_HBF), (const bf16_t*)(ws + WS_W1T), M, DIN, DM};
        pg8::StaticOrder S; S.init(M, DIN, G, (int)blockIdx.x);
        EpiProj E{(bf16_t*)(ws + WS_PROJ), (bf16_t*)(ws + WS_G), (float*)(ws + WS_KMEAN), (const float*)(ws + WS_CS)};
        pg8::gemm_phase<EpiProj, pg8::StaticOrder, true, true>(lds, g, S, E);
    }
    GRID_SYNC();

    p2_attention(a, (char*)lds_raw, G);
    GRID_SYNC();

    {
        pg8::Gemm g{(const bf16_t*)(ws + WS_Y), (const bf16_t*)(ws + WS_WABT), M, DM, DM};
        pg8::StaticOrder S; S.init(M, DM, G, (int)blockIdx.x);
        EpiMerge E{(const bf16_t*)(ws + WS_G), (bf16_t*)(ws + WS_MRG)};
        pg8::gemm_phase<EpiMerge, pg8::StaticOrder, true, true>(lds, g, S, E);
    }
    GRID_SYNC();

    {
        pg8::Gemm g{(const bf16_t*)(ws + WS_MRG), (const bf16_t*)(ws + WS_WOT), M, DM, DM};
        pg8::StaticOrder S; S.init(M, DM, G, (int)blockIdx.x);
        EpiX1 E{a.in[0], a.out, (bf16_t*)(ws + WS_HBF), (float*)(ws + WS_SSQ1)};
        pg8::gemm_phase<EpiX1, pg8::StaticOrder, true, true>(lds, g, S, E);
    }
    GRID_SYNC();

    {
        pg8::StaticOrder S; S.init(M, DM, G, (int)blockIdx.x);
        {
            pg8::Gemm g{(const bf16_t*)(ws + WS_PBF), (const bf16_t*)(ws + WS_WPPT), M, DM, DPLE};
            EpiPP E{(float*)(ws + WS_PPT)};
            pg8::gemm_phase<EpiPP, pg8::StaticOrder, true, true>(lds, g, S, E);
        }
        LAS float* rstd = (LAS float*)(lds + LDS_MISC + 1024);
        {
            Unit u; S.next(0, u);
            int tid = threadIdx.x; asm volatile("" : "+v"(tid));
            const int r = tid >> 1, hf = tid & 1;
            const f32x4* sp = (const f32x4*)((const float*)(ws + WS_SSQ1) + (size_t)(u.pm * 256 + r) * 32 + hf * 16);
            const f32x4 s0 = sp[0], s1 = sp[1], s2 = sp[2], s3 = sp[3];
            float ss = ((s0[0] + s0[1]) + (s0[2] + s0[3])) + ((s1[0] + s1[1]) + (s1[2] + s1[3])) + ((s2[0] + s2[1]) + (s2[2] + s2[3])) + ((s3[0] + s3[1]) + (s3[2] + s3[3]));
            ss += shx<1>(ss);
            if (hf == 0) rstd[r] = 1.0f / sqrtf(ss * (1.0f / DM) + EPS);
        }
        __syncthreads();
        {
            pg8::Gemm g{(const bf16_t*)(ws + WS_HBF), (const bf16_t*)(ws + WS_WPGT), M, DM, DM};
            EpiX2 E{(const float*)(ws + WS_PPT), a.out, (float*)(ws + WS_SSQ2), rstd};
            pg8::gemm_phase<EpiX2, pg8::StaticOrder, true, true>(lds, g, S, E);
        }
    }
    GRID_SYNC();

    {
        int t__ = threadIdx.x; asm volatile("" : "+v"(t__));
        const int lane = t__ & 63, wave = __builtin_amdgcn_readfirstlane(t__ >> 6);
        const int gw = blockIdx.x * 8 + wave, NGW = G * 8;
        const float* ssq = (const float*)(ws + WS_SSQ2); const float* gf = a.in[11];
        for (int m = gw; m < M; m += NGW) {
            float ss = (lane < 32) ? ssq[(size_t)m * 32 + lane] : 0.f;
            ss = wave_sum(ss);
            const float rstd = 1.0f / sqrtf(ss * (1.0f / DM) + EPS);
            f32x4* xr = (f32x4*)(a.out + (size_t)m * DM) + lane;
#pragma unroll
            for (int j = 0; j < 8; ++j) { const f32x4 gv = ((const f32x4*)gf)[lane + 64 * j]; f32x4 v = xr[64 * j]; v = v * rstd * gv; xr[64 * j] = v; }
        }
    }
}

extern "C" void kernel_launch(void* const* d_in, const int* in_sizes, int n_in, void* d_out, int out_size, void* d_ws, size_t ws_size, hipStream_t stream) {
    static int grid = 0;
    if (grid == 0) {
        if (n_in != 12 || out_size != M * DM || ws_size < WS_END) { fprintf(stderr, "kernel_launch: unexpected problem shape (n_in %d out %d ws %zu)\n", n_in, out_size, ws_size); grid = -1; return; }
        int dev = 0, cus = 0, per_cu = 0;
        (void)hipGetDevice(&dev);
        (void)hipDeviceGetAttribute(&cus, hipDeviceAttributeMultiprocessorCount, dev);
        if (hipFuncSetAttribute((const void*)mega_fwd, hipFuncAttributeMaxDynamicSharedMemorySize, LDS_BYTES) != hipSuccess) { fprintf(stderr, "kernel_launch: hipFuncSetAttribute failed\n"); grid = -1; return; }
        if (hipOccupancyMaxActiveBlocksPerMultiprocessor(&per_cu, (const void*)mega_fwd, 512, LDS_BYTES) != hipSuccess || per_cu < 1) { fprintf(stderr, "kernel_launch: occupancy query failed (%d)\n", per_cu); (void)hipGetLastError(); per_cu = 1; }
        grid = cus * 1;
        if (grid != 256) { fprintf(stderr, "kernel_launch: %d CUs; this kernel needs exactly 256 workgroups (one 256x256 unit each in P3..P5)\n", grid); grid = -1; return; }
    }
    if (grid < 0) return;
    if (hipMemsetAsync(d_ws, 0, 16384, stream) != hipSuccess) { fprintf(stderr, "kernel_launch: hipMemsetAsync failed\n"); return; }
    Args a{};
    for (int i = 0; i < 12; ++i) a.in[i] = (const float*)d_in[i];
    a.out = (float*)d_out; a.ws = (unsigned char*)d_ws;
    void* args[] = {&a};
    hipError_t e = hipLaunchCooperativeKernel((const void*)mega_fwd, dim3(grid), dim3(512), args, LDS_BYTES, stream);
    if (e != hipSuccess) fprintf(stderr, "kernel_launch: cooperative launch failed: %s (grid %d)\n", hipGetErrorString(e), grid);
}
```
